# Optimizing an MI355X kernel written in HIP

```python
import math
import jax, jax.numpy as jnp
from jax import lax
import numpy as np

D_MODEL = 2048
BATCH = 2
SEQ = 4096
DEPTH = 1

MOBA_HEADS = 8
MOBA_HEAD_DIM = 128
MOBA_WIDTH = MOBA_HEADS * MOBA_HEAD_DIM
MOBA_BLOCK = 256
MOBA_TOPK = 3
MOBA_Q_CHUNK = 32
DIFF_HEADS = 8
DIFF_QK_DIM = 64
DIFF_V_DIM = 2 * DIFF_QK_DIM
DIFF_QK_WIDTH = DIFF_HEADS * 2 * DIFF_QK_DIM
DIFF_WIDTH = DIFF_HEADS * DIFF_V_DIM
DIFF_Q_BLOCK = 128
ROPE_THETA = 10000.0
FFN_HIDDEN = ((8 * D_MODEL + 3 * 256 - 1) // (3 * 256)) * 256
LN_EPS = 1e-5
RMS_EPS = 1e-5
DEEPNORM_ALPHA = (2.0 * DEPTH) ** 0.25
DEEPNORM_BETA = (8.0 * DEPTH) ** -0.25
IN_SIZES = (MOBA_WIDTH, MOBA_WIDTH, MOBA_WIDTH,
            DIFF_QK_WIDTH, DIFF_QK_WIDTH, DIFF_WIDTH,
            D_MODEL, D_MODEL)
IN_COLS = sum(IN_SIZES)
IN_SPLITS = tuple(int(s) for s in np.cumsum(IN_SIZES)[:-1])

kernel_name = 'moba_diffattn_gated_deepnorm_block'


def _rope(t, pos):
    d = t.shape[-1]
    half = d // 2
    inv_freq = ROPE_THETA ** (-jnp.arange(half, dtype=jnp.float32) * 2.0 / d)
    ang = pos.astype(jnp.float32)[:, None] * inv_freq[None, :]
    shape = (pos.shape[0],) + (1,) * (t.ndim - 3) + (half,)
    cos = jnp.cos(ang).reshape(shape)
    sin = jnp.sin(ang).reshape(shape)
    tf = t.astype(jnp.float32)
    t1, t2 = tf[..., :half], tf[..., half:]
    return jnp.concatenate([t1 * cos - t2 * sin, t2 * cos + t1 * sin], axis=-1).astype(t.dtype)


def _layer_norm(t, g, b):
    tf = t.astype(jnp.float32)
    mu = jnp.mean(tf, axis=-1, keepdims=True)
    var = jnp.mean(jnp.square(tf - mu), axis=-1, keepdims=True)
    return ((tf - mu) * lax.rsqrt(var + LN_EPS) * g.astype(jnp.float32) + b.astype(jnp.float32)).astype(t.dtype)


def _moba_attention(q, k, v):
    B, S, H, Dh = q.shape
    nb = -(-S // MOBA_BLOCK)
    s_pad = nb * MOBA_BLOCK
    pad = ((0, 0), (0, s_pad - S), (0, 0), (0, 0))
    qh = jnp.pad(q, pad).astype(jnp.float32).transpose(0, 2, 1, 3)
    kb = jnp.pad(k, pad).astype(jnp.float32).transpose(0, 2, 1, 3).reshape(B, H, nb, MOBA_BLOCK, Dh)
    vb = jnp.pad(v, pad).astype(jnp.float32).transpose(0, 2, 1, 3).reshape(B, H, nb, MOBA_BLOCK, Dh)
    k_mean = jnp.mean(kb, axis=3)
    gate = jnp.einsum('bhsd,bhnd->bhsn', qh, k_mean)
    q_blk = jnp.arange(s_pad) // MOBA_BLOCK
    past = jnp.arange(nb)[None, :] < q_blk[:, None]
    gate = jnp.where(past[None, None], gate, -jnp.inf)
    topk = min(MOBA_TOPK, nb)
    _, sel = lax.top_k(gate, topk)
    sel_valid = jnp.arange(topk)[None, :] < q_blk[:, None]
    C = MOBA_Q_CHUNK
    n_chunk = s_pad // C
    q_c = qh.reshape(B, H, n_chunk, C, Dh).transpose(2, 0, 1, 3, 4)
    sel_c = sel.reshape(B, H, n_chunk, C, topk).transpose(2, 0, 1, 3, 4)
    valid_c = sel_valid.reshape(n_chunk, C, topk)
    scale = Dh ** -0.5
    bi = jnp.arange(B)[:, None, None, None]
    hi = jnp.arange(H)[None, :, None, None]
    key_off = jnp.arange(MOBA_BLOCK)

    def chunk_fn(args):
        c, qc, selc, validc = args
        kg = kb[bi, hi, selc]
        vg = vb[bi, hi, selc]
        s_sel = jnp.einsum('bhcd,bhcjkd->bhcjk', qc, kg) * scale
        s_sel = jnp.where(validc[None, None, :, :, None], s_sel, -jnp.inf).reshape(B, H, C, topk * MOBA_BLOCK)
        blk = (c * C) // MOBA_BLOCK
        k_own = lax.dynamic_index_in_dim(kb, blk, axis=2, keepdims=False)
        v_own = lax.dynamic_index_in_dim(vb, blk, axis=2, keepdims=False)
        s_own = jnp.einsum('bhcd,bhkd->bhck', qc, k_own) * scale
        q_off = (c * C) % MOBA_BLOCK + jnp.arange(C)
        s_own = jnp.where(key_off[None, :] <= q_off[:, None], s_own, -jnp.inf)
        p = jax.nn.softmax(jnp.concatenate([s_sel, s_own], axis=-1), axis=-1)
        p_sel = p[..., :topk * MOBA_BLOCK].reshape(B, H, C, topk, MOBA_BLOCK)
        p_own = p[..., topk * MOBA_BLOCK:]
        return (jnp.einsum('bhcjk,bhcjkd->bhcd', p_sel, vg)
                + jnp.einsum('bhck,bhkd->bhcd', p_own, v_own))

    out = lax.map(chunk_fn, (jnp.arange(n_chunk), q_c, sel_c, valid_c))
    out = out.transpose(1, 0, 3, 2, 4).reshape(B, s_pad, H * Dh)
    return out[:, :S]


def _diff_attention(q, k, v, lam, subln_w, lam_init):
    B, S, H, _, dq = q.shape
    dv = v.shape[-1]
    qh = q.astype(jnp.float32).transpose(0, 2, 3, 1, 4)
    kh = k.astype(jnp.float32).transpose(0, 2, 3, 1, 4)
    vh = v.astype(jnp.float32).transpose(0, 2, 1, 3)
    nq = S // DIFF_Q_BLOCK
    q_blocks = qh.reshape(B, H, 2, nq, DIFF_Q_BLOCK, dq).transpose(3, 0, 1, 2, 4, 5)
    kpos = jnp.arange(S)
    scale = dq ** -0.5

    def block_fn(args):
        i, qb = args
        s = jnp.einsum('bhmqd,bhmkd->bhmqk', qb, kh) * scale
        qpos = i * DIFF_Q_BLOCK + jnp.arange(DIFF_Q_BLOCK)
        s = jnp.where(kpos[None, :] <= qpos[:, None], s, -jnp.inf)
        p = jax.nn.softmax(s, axis=-1)
        a = p[:, :, 0] - lam * p[:, :, 1]
        return jnp.einsum('bhqk,bhkd->bhqd', a, vh)

    o = lax.map(block_fn, (jnp.arange(nq), q_blocks))
    o = o.transpose(1, 0, 3, 2, 4).reshape(B, S, H, dv)
    o = o * lax.rsqrt(jnp.mean(jnp.square(o), axis=-1, keepdims=True) + RMS_EPS)
    o = o * subln_w.astype(jnp.float32) * (1.0 - lam_init)
    return o.reshape(B, S, H * dv)


def _mixer(h, w_in, lambda_qk, subln_w, w_branch_a, w_branch_b, w_out, lam_init):
    B, S, _ = h.shape
    pos = jnp.arange(S)
    z = h @ w_in
    qa, ka, va, qb, kb, vb, ga, gb = jnp.split(z, IN_SPLITS, axis=-1)
    qa = _rope(qa.reshape(B, S, MOBA_HEADS, MOBA_HEAD_DIM), pos)
    ka = _rope(ka.reshape(B, S, MOBA_HEADS, MOBA_HEAD_DIM), pos)
    va = va.reshape(B, S, MOBA_HEADS, MOBA_HEAD_DIM)
    y_a = _moba_attention(qa, ka, va).astype(h.dtype)
    lq = lambda_qk.astype(jnp.float32)
    lam = jnp.exp(jnp.sum(lq[0] * lq[1])) - jnp.exp(jnp.sum(lq[2] * lq[3])) + lam_init
    qb = _rope(qb.reshape(B, S, DIFF_HEADS, 2, DIFF_QK_DIM), pos)
    kb = _rope(kb.reshape(B, S, DIFF_HEADS, 2, DIFF_QK_DIM), pos)
    vb = vb.reshape(B, S, DIFF_HEADS, DIFF_V_DIM)
    y_b = _diff_attention(qb, kb, vb, lam, subln_w, lam_init).astype(h.dtype)
    m = jax.nn.sigmoid(ga) * (y_a @ w_branch_a) + jax.nn.sigmoid(gb) * (y_b @ w_branch_b)
    return m @ w_out


def _swiglu(h, w_ffn_in, w_ffn_out):
    g, u = jnp.split(h @ w_ffn_in, 2, axis=-1)
    return (jax.nn.silu(g) * u) @ w_ffn_out


def setup_inputs(seed: int = 0) -> dict:
    key = jax.random.key(seed)
    ks = jax.random.split(key, 14)
    f32 = jnp.float32
    col_scale = np.ones((IN_COLS,), np.float32)
    starts = (0,) + IN_SPLITS
    for idx in (2, 5):
        col_scale[starts[idx]:starts[idx] + IN_SIZES[idx]] = DEEPNORM_BETA
    x = jax.random.normal(ks[0], (BATCH, SEQ, D_MODEL), f32)
    w_in = jax.random.normal(ks[1], (DEPTH, D_MODEL, IN_COLS), f32) * (D_MODEL ** -0.5) * jnp.asarray(col_scale)
    lambda_qk = 0.1 * jax.random.normal(ks[2], (DEPTH, 4, DIFF_QK_DIM), f32)
    diff_subln_w = 1.0 + 0.02 * jax.random.normal(ks[3], (DEPTH, DIFF_V_DIM), f32)
    w_branch_a = jax.random.normal(ks[4], (DEPTH, MOBA_WIDTH, D_MODEL), f32) * (MOBA_WIDTH ** -0.5) * DEEPNORM_BETA
    w_branch_b = jax.random.normal(ks[5], (DEPTH, DIFF_WIDTH, D_MODEL), f32) * (DIFF_WIDTH ** -0.5) * DEEPNORM_BETA
    w_out = jax.random.normal(ks[6], (DEPTH, D_MODEL, D_MODEL), f32) * (D_MODEL ** -0.5) * DEEPNORM_BETA
    ln1_g = 1.0 + 0.02 * jax.random.normal(ks[7], (DEPTH, D_MODEL), f32)
    ln1_b = 0.02 * jax.random.normal(ks[8], (DEPTH, D_MODEL), f32)
    w_ffn_in = jax.random.normal(ks[9], (DEPTH, D_MODEL, 2 * FFN_HIDDEN), f32) * (D_MODEL ** -0.5) * DEEPNORM_BETA
    w_ffn_out = jax.random.normal(ks[10], (DEPTH, FFN_HIDDEN, D_MODEL), f32) * (FFN_HIDDEN ** -0.5) * DEEPNORM_BETA
    ln2_g = 1.0 + 0.02 * jax.random.normal(ks[11], (DEPTH, D_MODEL), f32)
    ln2_b = 0.02 * jax.random.normal(ks[12], (DEPTH, D_MODEL), f32)
    return {'x': x, 'w_in': w_in, 'lambda_qk': lambda_qk, 'diff_subln_w': diff_subln_w,
            'w_branch_a': w_branch_a, 'w_branch_b': w_branch_b, 'w_out': w_out,
            'ln1_g': ln1_g, 'ln1_b': ln1_b, 'w_ffn_in': w_ffn_in, 'w_ffn_out': w_ffn_out,
            'ln2_g': ln2_g, 'ln2_b': ln2_b}


def reference(x, w_in, lambda_qk, diff_subln_w, w_branch_a, w_branch_b, w_out,
              ln1_g, ln1_b, w_ffn_in, w_ffn_out, ln2_g, ln2_b):
    h = x
    for l in range(DEPTH):
        lam_init = 0.8 - 0.6 * math.exp(-0.3 * l)
        mix = _mixer(h, w_in[l], lambda_qk[l], diff_subln_w[l], w_branch_a[l], w_branch_b[l], w_out[l], lam_init)
        h = _layer_norm(DEEPNORM_ALPHA * h + mix, ln1_g[l], ln1_b[l])
        h = _layer_norm(DEEPNORM_ALPHA * h + _swiglu(h, w_ffn_in[l], w_ffn_out[l]), ln2_g[l], ln2_b[l])
    return h
```

```cpp
#include <hip/hip_runtime.h>
#include <hip/hip_cooperative_groups.h>
#include <cstdio>
#include <cstdint>
#include <cmath>
namespace pg8 {
#define PG8_LAS __attribute__((address_space(3)))
typedef unsigned short bf16_t;
typedef short bf16x8 __attribute__((ext_vector_type(8)));
typedef float f32x4 __attribute__((ext_vector_type(4)));
typedef unsigned u32x4 __attribute__((ext_vector_type(4)));
constexpr int BM = 256, BK = 64, HALF = 128, HTB = HALF * BK * 2  , STAGE_BYTES = 8 * HTB, NXCD = 8, WGM = 8;

__host__ __device__ __forceinline__ int lds_byte(int r, int c) { const int st = (r >> 4) * 2 + (c >> 5), rr = r & 15, cc = c & 31, ob = rr * 64 + cc * 2; return st * 1024 + (ob ^ (((ob >> 9) & 1) << 5)); }
__host__ __device__ __forceinline__ void stage_rc(int b, int& R, int& C) { const int st = b / 1024, sb = b % 1024, swz = sb ^ (((sb >> 9) & 1) << 5); R = (st >> 1) * 16 + swz / 64; C = (st & 1) * 32 + (swz % 64) / 2; }
__host__ __device__ __forceinline__ int perm32(int rho) { const int n = rho >> 4, i = rho & 15; return 8 * (i >> 2) + 4 * n + (i & 3); }

struct Unit { int pm, pn; };
struct Gemm { const bf16_t* A; const bf16_t* Bt; int M, N, K; };

struct StaticOrder {
    int nM, nN, nwg, G, c;
    __host__ __device__ void init(int M, int N, int G_, int c_) { nM = M / BM; nN = N / BM; nwg = nM * nN; G = G_; c = c_; }
    __host__ __device__ bool next(int i, Unit& u) const {
        const long L = (long)i * G + c; if (L >= nwg) return false;
        int wgid = (int)L; { const int q = nwg / NXCD, r = nwg % NXCD, xcd = wgid % NXCD, off = wgid / NXCD; wgid = (xcd < r ? xcd * (q + 1) : r * (q + 1) + (xcd - r) * q) + off; }
        const int nig = WGM * nN, gid = wgid / nig, fm = gid * WGM, gsz = (nM - fm) < WGM ? (nM - fm) : WGM;
        u.pm = fm + ((wgid % nig) % gsz); u.pn = (wgid % nig) / gsz; return true;
    }
    __device__ __forceinline__ void a_ready(const Unit&) const {}
    __device__ __forceinline__ void done(const Unit&) const {}
};

typedef float f32x2c_t __attribute__((ext_vector_type(2))); typedef __bf16 bf16x2c_t __attribute__((ext_vector_type(2)));
__device__ __forceinline__ unsigned cvt_pk_bf16(float lo, float hi) { f32x2c_t v = {lo, hi}; bf16x2c_t b = __builtin_convertvector(v, bf16x2c_t); return __builtin_bit_cast(unsigned, b); }
typedef float f32x2 __attribute__((ext_vector_type(2)));
typedef unsigned u32x2 __attribute__((ext_vector_type(2)));
__device__ __forceinline__ float fast_sigmoid(float v) { return __builtin_amdgcn_rcpf(1.0f + __builtin_amdgcn_exp2f(-1.4426950408889634f * v)); }
__device__ __forceinline__ float bf_lo(unsigned w) { return __uint_as_float(w << 16); }
__device__ __forceinline__ float bf_hi(unsigned w) { return __uint_as_float(w & 0xffff0000u); }

struct EpiStore {
    static constexpr bool PERM = true, AFTER_DRAIN = false;
    bf16_t* O; int ldc;
    __device__ __forceinline__ void operator()(const f32x4 (&acc)[2][2][4][2], const Unit& u, int wr, int wc, int fr, int fq) const {
        const int row0 = u.pm * BM + wr * 64 + fr, col0 = u.pn * BM + wc * 32 + 8 * fq;
#pragma unroll
        for (int ai = 0; ai < 2; ++ai)
#pragma unroll
            for (int m = 0; m < 4; ++m) { bf16_t* rowp = O + (size_t)(row0 + ai * HALF + m * 16) * ldc + col0;
#pragma unroll
                for (int bj = 0; bj < 2; ++bj) { const f32x4 v0 = acc[ai][bj][m][0], v1 = acc[ai][bj][m][1];
                    u32x4 w; w.x = cvt_pk_bf16(v0[0], v0[1]); w.y = cvt_pk_bf16(v0[2], v0[3]); w.z = cvt_pk_bf16(v1[0], v1[1]); w.w = cvt_pk_bf16(v1[2], v1[3]);
                    *(u32x4*)(rowp + bj * HALF) = w; } }
    }
};

struct EpiIn {
    static constexpr bool PERM = true, AFTER_DRAIN = false;
    bf16_t* QK;
    bf16_t* SG;
    const float* T128;
    const float* T64;
    float* kmean;
    float scA, scB;
    __device__ __forceinline__ void operator()(const f32x4 (&acc)[2][2][4][2], const Unit& u, int wr, int wc, int fr, int fq) const {
        const int pn = u.pn, row0 = u.pm * BM + wr * 64 + fr;
        if (pn >= 16) {
            const int col0 = (pn - 16) * BM + wc * 32 + 8 * fq;
#pragma unroll
            for (int ai = 0; ai < 2; ++ai)
#pragma unroll
                for (int m = 0; m < 4; ++m) { bf16_t* rowp = SG + (size_t)(row0 + ai * HALF + m * 16) * 4096 + col0;
#pragma unroll
                    for (int bj = 0; bj < 2; ++bj) { const f32x4 v0 = acc[ai][bj][m][0], v1 = acc[ai][bj][m][1];
                        u32x4 w; w.x = cvt_pk_bf16(fast_sigmoid(v0[0]), fast_sigmoid(v0[1])); w.y = cvt_pk_bf16(fast_sigmoid(v0[2]), fast_sigmoid(v0[3]));
                        w.z = cvt_pk_bf16(fast_sigmoid(v1[0]), fast_sigmoid(v1[1])); w.w = cvt_pk_bf16(fast_sigmoid(v1[2]), fast_sigmoid(v1[3]));
                        *(u32x4*)(rowp + bj * HALF) = w; } }
            return;
        }
        const int region = pn >> 2; const bool is64 = region >= 2;
        const float sc = region == 0 ? scA : (region == 2 ? scB : 1.0f);
        const int half = is64 ? 32 : 64;
        const int d0 = is64 ? 4 * (4 * (wc & 1) + fq) : 4 * (4 * wc + fq);
        const int cin = is64 ? (wc >> 1) * 64 + d0 : d0;
        const float* tab = is64 ? T64 : T128;
        bf16_t* base = QK + (size_t)region * ((size_t)8192 * 1024) + (pn & 3) * 256 + cin;
#pragma unroll
        for (int ai = 0; ai < 2; ++ai)
#pragma unroll
            for (int m = 0; m < 4; ++m) { const int row = row0 + ai * HALF + m * 16, pos = row & 4095;
                const f32x4 cv = *(const f32x4*)(tab + (size_t)pos * half + d0), sv = *(const f32x4*)(tab + (size_t)(4096 + pos) * half + d0);
                bf16_t* rowp = base + (size_t)row * 1024;
#pragma unroll
                for (int bj = 0; bj < 2; ++bj) { const f32x4 x1 = acc[ai][bj][m][0], x2 = acc[ai][bj][m][1];
                    const f32x4 o1 = (x1 * cv - x2 * sv) * sc, o2 = (x2 * cv + x1 * sv) * sc;
                    u32x2 w1, w2; w1.x = cvt_pk_bf16(o1[0], o1[1]); w1.y = cvt_pk_bf16(o1[2], o1[3]); w2.x = cvt_pk_bf16(o2[0], o2[1]); w2.y = cvt_pk_bf16(o2[2], o2[3]);
                    *(u32x2*)(rowp + bj * HALF) = w1; *(u32x2*)(rowp + bj * HALF + half) = w2;
                    }
                asm volatile("" ::: "memory"); }
        if (region == 1) {
            f32x4 ks[2][2];
#pragma unroll
            for (int bj = 0; bj < 2; ++bj) { ks[bj][0] = (f32x4){0.f, 0.f, 0.f, 0.f}; ks[bj][1] = (f32x4){0.f, 0.f, 0.f, 0.f}; }
#pragma unroll
            for (int ai = 0; ai < 2; ++ai)
#pragma unroll
                for (int m = 0; m < 4; ++m) { const int row = row0 + ai * HALF + m * 16, pos = row & 4095;
                    const f32x4 cv = *(const f32x4*)(tab + (size_t)pos * half + d0), sv = *(const f32x4*)(tab + (size_t)(4096 + pos) * half + d0);
#pragma unroll
                    for (int bj = 0; bj < 2; ++bj) { const f32x4 x1 = acc[ai][bj][m][0], x2 = acc[ai][bj][m][1];
                        ks[bj][0] += x1 * cv - x2 * sv; ks[bj][1] += x2 * cv + x1 * sv; }
                    asm volatile("" ::: "memory"); }
#pragma unroll
            for (int bj = 0; bj < 2; ++bj)
#pragma unroll
                for (int n = 0; n < 2; ++n)
#pragma unroll
                    for (int j = 0; j < 4; ++j) { float v = ks[bj][n][j]; v += __shfl_xor(v, 1); v += __shfl_xor(v, 2); v += __shfl_xor(v, 4); v += __shfl_xor(v, 8); ks[bj][n][j] = v; }
            if (fr == 0) { const int b = u.pm >> 4, blk = u.pm & 15;
#pragma unroll
                for (int bj = 0; bj < 2; ++bj) { float* kp = kmean + ((size_t)((b * 8 + (pn & 3) * 2 + bj) * 16 + blk)) * 128 + d0;
#pragma unroll
                    for (int n = 0; n < 2; ++n)
#pragma unroll
                        for (int j = 0; j < 4; ++j) atomicAdd(kp + n * 64 + j, ks[bj][n][j] * (1.0f / 256.0f)); } }
        }
    }
};

struct EpiBrA {
    static constexpr bool PERM = true, AFTER_DRAIN = false;
    float* T; const bf16_t* SG;
    __device__ __forceinline__ void operator()(const f32x4 (&acc)[2][2][4][2], const Unit& u, int wr, int wc, int fr, int fq) const {
        const int row0 = u.pm * BM + wr * 64 + fr, col0 = u.pn * BM + wc * 32 + 8 * fq;
#pragma unroll
        for (int ai = 0; ai < 2; ++ai)
#pragma unroll
            for (int m = 0; m < 4; ++m) { const size_t row = (size_t)(row0 + ai * HALF + m * 16);
#pragma unroll
                for (int bj = 0; bj < 2; ++bj) { const u32x4 s = *(const u32x4*)(SG + row * 4096 + col0 + bj * HALF);
                    const f32x4 v0 = acc[ai][bj][m][0], v1 = acc[ai][bj][m][1];
                    f32x4 t0, t1; t0[0] = bf_lo(s.x) * v0[0]; t0[1] = bf_hi(s.x) * v0[1]; t0[2] = bf_lo(s.y) * v0[2]; t0[3] = bf_hi(s.y) * v0[3];
                    t1[0] = bf_lo(s.z) * v1[0]; t1[1] = bf_hi(s.z) * v1[1]; t1[2] = bf_lo(s.w) * v1[2]; t1[3] = bf_hi(s.w) * v1[3];
                    float* tp = T + row * 2048 + col0 + bj * HALF; *(f32x4*)tp = t0; *(f32x4*)(tp + 4) = t1; } }
    }
};
struct EpiBrB {
    static constexpr bool PERM = true, AFTER_DRAIN = false;
    const float* T; const bf16_t* SG; bf16_t* MB;
    __device__ __forceinline__ void operator()(const f32x4 (&acc)[2][2][4][2], const Unit& u, int wr, int wc, int fr, int fq) const {
        const int row0 = u.pm * BM + wr * 64 + fr, col0 = u.pn * BM + wc * 32 + 8 * fq;
#pragma unroll
        for (int ai = 0; ai < 2; ++ai)
#pragma unroll
            for (int m = 0; m < 4; ++m) { const size_t row = (size_t)(row0 + ai * HALF + m * 16);
#pragma unroll
                for (int bj = 0; bj < 2; ++bj) { const u32x4 s = *(const u32x4*)(SG + row * 4096 + 2048 + col0 + bj * HALF);
                    const float* tp = T + row * 2048 + col0 + bj * HALF; const f32x4 a0 = *(const f32x4*)tp, a1 = *(const f32x4*)(tp + 4);
                    const f32x4 v0 = acc[ai][bj][m][0], v1 = acc[ai][bj][m][1];
                    u32x4 w; w.x = cvt_pk_bf16(a0[0] + bf_lo(s.x) * v0[0], a0[1] + bf_hi(s.x) * v0[1]); w.y = cvt_pk_bf16(a0[2] + bf_lo(s.y) * v0[2], a0[3] + bf_hi(s.y) * v0[3]);
                    w.z = cvt_pk_bf16(a1[0] + bf_lo(s.z) * v1[0], a1[1] + bf_hi(s.z) * v1[1]); w.w = cvt_pk_bf16(a1[2] + bf_lo(s.w) * v1[2], a1[3] + bf_hi(s.w) * v1[3]);
                    *(u32x4*)(MB + row * 2048 + col0 + bj * HALF) = w; } }
    }
};
struct EpiRes {
    static constexpr bool PERM = false, AFTER_DRAIN = false;
    const float* base; float* out; float alpha;
    __device__ __forceinline__ void operator()(const f32x4 (&acc)[2][2][4][2], const Unit& u, int wr, int wc, int fr, int fq) const {
        const int row0 = u.pm * BM + wr * 64 + fr, col0 = u.pn * BM + wc * 32 + 4 * fq;
#pragma unroll
        for (int ai = 0; ai < 2; ++ai)
#pragma unroll
            for (int m = 0; m < 4; ++m) { const size_t off = (size_t)(row0 + ai * HALF + m * 16) * 2048 + col0;
#pragma unroll
                for (int bj = 0; bj < 2; ++bj)
#pragma unroll
                    for (int n = 0; n < 2; ++n) { const f32x4 b = *(const f32x4*)(base + off + bj * HALF + n * 16); *(f32x4*)(out + off + bj * HALF + n * 16) = b * alpha + acc[ai][bj][m][n]; } }
    }
};
struct EpiSwiglu {
    static constexpr bool PERM = true, AFTER_DRAIN = false;
    bf16_t* H;
    __device__ __forceinline__ void operator()(const f32x4 (&acc)[2][2][4][2], const Unit& u, int wr, int wc, int fr, int fq) const {
        const int row0 = u.pm * BM + wr * 64 + fr, col0 = u.pn * HALF + wc * 32 + 8 * fq;
#pragma unroll
        for (int ai = 0; ai < 2; ++ai)
#pragma unroll
            for (int m = 0; m < 4; ++m) { const f32x4 g0 = acc[ai][0][m][0], g1 = acc[ai][0][m][1], u0 = acc[ai][1][m][0], u1 = acc[ai][1][m][1];
                f32x4 h0, h1;
#pragma unroll
                for (int j = 0; j < 4; ++j) { h0[j] = g0[j] * fast_sigmoid(g0[j]) * u0[j]; h1[j] = g1[j] * fast_sigmoid(g1[j]) * u1[j]; }
                u32x4 w; w.x = cvt_pk_bf16(h0[0], h0[1]); w.y = cvt_pk_bf16(h0[2], h0[3]); w.z = cvt_pk_bf16(h1[0], h1[1]); w.w = cvt_pk_bf16(h1[2], h1[3]);
                *(u32x4*)(H + (size_t)(row0 + ai * HALF + m * 16) * 5632 + col0) = w; }
    }
};
template <class Epi, class Sched, bool ALIGN_EPI = false, bool SP2 = false>
__device__ __forceinline__ void gemm_phase(PG8_LAS unsigned char* lds, const Gemm g, const Sched& S, const Epi& E) {
    const int tid = threadIdx.x, wid = __builtin_amdgcn_readfirstlane(tid >> 6), lane = tid & 63, wr = wid >> 2, wc = wid & 3, fr = lane & 15, fq = lane >> 4;
    const int K = g.K, nt = K / BK;
    unsigned voffA[2], voffB[2];
#pragma unroll
    for (int i = 0; i < 2; ++i) { int R, C; stage_rc(tid * 16 + i * 8192, R, C); const int Rb = Epi::PERM ? ((R & ~31) + perm32(R & 31)) : R;
        voffA[i] = (unsigned)(R * K + C) * 2u; voffB[i] = (unsigned)(Rb * K + C) * 2u; }
    const size_t kstep = (size_t)(BK * 2);
    const size_t hstep = (size_t)HALF * K * 2;
    const size_t tstep = 2 * hstep;
    const unsigned ldsw = (unsigned)wid * 1024u;
    const int aoff = lds_byte(wr * 64 + fr, fq * 8), boff = lds_byte(wc * 32 + fr, fq * 8);
#define PG8_SA(b, h) (((b) * 2 + (h)) * HTB)
#define PG8_SB(b, h) ((4 + (b) * 2 + (h)) * HTB)
#define PG8_STAGE(bufoff, gbase, voff) do { _Pragma("unroll") for (int _i = 0; _i < 2; ++_i) \
        __builtin_amdgcn_global_load_lds((const unsigned*)((const char*)(gbase) + (voff)[_i]), (PG8_LAS unsigned*)(lds + (bufoff) + ldsw + _i * 8192), 16, 0, 0); } while (0)
#define PG8_LDA(dst, b, h) do { _Pragma("unroll") for (int m = 0; m < 4; ++m) _Pragma("unroll") for (int k = 0; k < 2; ++k) dst[m][k] = *(const PG8_LAS bf16x8*)(lds + PG8_SA(b, h) + aoff + m * 2048 + k * 1024); } while (0)
#define PG8_LDB(dst, b, h) do { _Pragma("unroll") for (int n = 0; n < 2; ++n) _Pragma("unroll") for (int k = 0; k < 2; ++k) dst[n][k] = *(const PG8_LAS bf16x8*)(lds + PG8_SB(b, h) + boff + n * 2048 + k * 1024); } while (0)
#define PG8_MMA(ai, bj, At, Bt) do { __builtin_amdgcn_s_setprio(1); _Pragma("unroll") for (int m = 0; m < 4; ++m) _Pragma("unroll") for (int n = 0; n < 2; ++n) _Pragma("unroll") for (int k = 0; k < 2; ++k) \
        acc[ai][bj][m][n] = __builtin_amdgcn_mfma_f32_16x16x32_bf16(Bt[n][k], At[m][k], acc[ai][bj][m][n], 0, 0, 0); __builtin_amdgcn_s_setprio(0); } while (0)
#define PG8_WAIT_V(n) asm volatile("s_waitcnt vmcnt(" #n ")" ::: "memory")
#define PG8_WAIT_L(n) asm volatile("s_waitcnt lgkmcnt(" #n ")" ::: "memory")
#define PG8_BAR __builtin_amdgcn_s_barrier()
#define PG8_SCHED __builtin_amdgcn_sched_barrier(0)
    Unit cur, nxt; int ui = 0;
    if (!S.next(0, cur)) return;
    f32x4 acc[2][2][4][2];
#pragma unroll
    for (int a = 0; a < 2; ++a)
#pragma unroll
        for (int b = 0; b < 2; ++b)
#pragma unroll
            for (int m = 0; m < 4; ++m)
#pragma unroll
                for (int n = 0; n < 2; ++n) acc[a][b][m][n] = (f32x4){0.f, 0.f, 0.f, 0.f};
    bf16x8 At[4][2], B0[2][2], B1[2][2];
    const char* cA = (const char*)g.A + (size_t)cur.pm * tstep; const char* cB = (const char*)g.Bt + (size_t)cur.pn * tstep;
    S.a_ready(cur);
    if constexpr (SP2) {
        PG8_STAGE(PG8_SB(0, 0), cB, voffB); PG8_STAGE(PG8_SB(0, 1), cB + hstep, voffB); PG8_STAGE(PG8_SA(0, 0), cA, voffA); PG8_STAGE(PG8_SA(0, 1), cA + hstep, voffA);
        if (wr == 1) PG8_BAR;
        PG8_WAIT_V(2); PG8_BAR;
        PG8_STAGE(PG8_SB(1, 0), cB + kstep, voffB); PG8_STAGE(PG8_SA(1, 0), cA + kstep, voffA); PG8_STAGE(PG8_SB(1, 1), cB + hstep + kstep, voffB);
        PG8_WAIT_V(6); PG8_BAR;
    } else {
        PG8_STAGE(PG8_SB(0, 0), cB, voffB); PG8_STAGE(PG8_SA(0, 0), cA, voffA); PG8_STAGE(PG8_SB(0, 1), cB + hstep, voffB); PG8_STAGE(PG8_SA(0, 1), cA + hstep, voffA);
        if (wr == 1) PG8_BAR;
        PG8_WAIT_V(4); PG8_BAR;
        PG8_STAGE(PG8_SB(1, 0), cB + kstep, voffB); PG8_STAGE(PG8_SA(1, 0), cA + kstep, voffA); PG8_STAGE(PG8_SB(1, 1), cB + hstep + kstep, voffB);
        PG8_WAIT_V(6); PG8_BAR;
    }
    for (;;) {
        const bool has_next = S.next(ui + 1, nxt);
        const char* nA = has_next ? (const char*)g.A + (size_t)nxt.pm * tstep : cA; const char* nB = has_next ? (const char*)g.Bt + (size_t)nxt.pn * tstep : cB;
        for (int t = 0; t < nt; t += 2) {
            const bool last = (t == nt - 2);
            const char* a1 = cA + (size_t)(t + 1) * kstep;
            const char* a2 = last ? nA : cA + (size_t)(t + 2) * kstep; const char* b2 = last ? nB : cB + (size_t)(t + 2) * kstep;
            const char* a3 = a2 + kstep; const char* b3 = b2 + kstep;
            if (last && has_next) S.a_ready(nxt);
            if constexpr (SP2) {
            PG8_LDB(B0, 0, 0); PG8_LDB(B1, 0, 1); PG8_SCHED; PG8_LDA(At, 0, 0); PG8_STAGE(PG8_SA(1, 1), a1 + hstep, voffA);
            PG8_WAIT_V(8); PG8_WAIT_L(0); PG8_BAR; PG8_MMA(0, 0, At, B0); PG8_MMA(0, 1, At, B1); PG8_BAR; PG8_SCHED;
            PG8_LDA(At, 0, 1); PG8_STAGE(PG8_SB(0, 0), b2, voffB); PG8_STAGE(PG8_SB(0, 1), b2 + hstep, voffB); PG8_STAGE(PG8_SA(0, 0), a2, voffA);
            PG8_WAIT_V(8); PG8_WAIT_L(0); PG8_BAR; PG8_MMA(1, 0, At, B0); PG8_MMA(1, 1, At, B1); PG8_BAR; PG8_SCHED;
            PG8_LDB(B0, 1, 0); PG8_LDB(B1, 1, 1); PG8_SCHED; PG8_LDA(At, 1, 0); PG8_STAGE(PG8_SA(0, 1), a2 + hstep, voffA);
            PG8_WAIT_V(8); PG8_WAIT_L(0); PG8_BAR; PG8_MMA(0, 0, At, B0); PG8_MMA(0, 1, At, B1); PG8_BAR; PG8_SCHED;
            PG8_LDA(At, 1, 1); PG8_STAGE(PG8_SB(1, 0), b3, voffB); PG8_STAGE(PG8_SB(1, 1), b3 + hstep, voffB); PG8_STAGE(PG8_SA(1, 0), a3, voffA);
            PG8_WAIT_V(8); PG8_WAIT_L(0); PG8_BAR; PG8_MMA(1, 0, At, B0); PG8_MMA(1, 1, At, B1); PG8_BAR; PG8_SCHED;
            } else {
            PG8_LDB(B0, 0, 0); PG8_SCHED; PG8_LDA(At, 0, 0); PG8_STAGE(PG8_SA(1, 1), a1 + hstep, voffA);
            PG8_WAIT_L(8); PG8_BAR; PG8_WAIT_L(0); PG8_MMA(0, 0, At, B0); PG8_BAR; PG8_SCHED;
            PG8_LDB(B1, 0, 1); PG8_STAGE(PG8_SB(0, 0), b2, voffB);
            PG8_BAR; PG8_WAIT_L(0); PG8_MMA(0, 1, At, B1); PG8_BAR;
            PG8_LDA(At, 0, 1); PG8_STAGE(PG8_SA(0, 0), a2, voffA);
            PG8_BAR; PG8_WAIT_L(0); PG8_MMA(1, 0, At, B0); PG8_BAR; PG8_SCHED;
            PG8_STAGE(PG8_SB(0, 1), b2 + hstep, voffB);
            PG8_WAIT_V(6); PG8_BAR; PG8_MMA(1, 1, At, B1); PG8_BAR;
            PG8_LDB(B0, 1, 0); PG8_SCHED; PG8_LDA(At, 1, 0); PG8_STAGE(PG8_SA(0, 1), a2 + hstep, voffA);
            PG8_WAIT_L(8); PG8_BAR; PG8_WAIT_L(0); PG8_MMA(0, 0, At, B0); PG8_BAR; PG8_SCHED;
            PG8_LDB(B1, 1, 1); PG8_STAGE(PG8_SB(1, 0), b3, voffB);
            PG8_BAR; PG8_WAIT_L(0); PG8_MMA(0, 1, At, B1); PG8_BAR;
            PG8_LDA(At, 1, 1); PG8_STAGE(PG8_SA(1, 0), a3, voffA);
            PG8_BAR; PG8_WAIT_L(0); PG8_MMA(1, 0, At, B0); PG8_BAR; PG8_SCHED;
            PG8_STAGE(PG8_SB(1, 1), b3 + hstep, voffB);
            PG8_WAIT_V(6); PG8_BAR; PG8_MMA(1, 1, At, B1); PG8_BAR;
            }
        }
        if constexpr (ALIGN_EPI) { if (wr == 0) PG8_BAR; }
        if constexpr (!Epi::AFTER_DRAIN) { E(acc, cur, wr, wc, fr, fq); S.done(cur); }
        if (!has_next) break;
#pragma unroll
        for (int a = 0; a < 2; ++a)
#pragma unroll
            for (int b = 0; b < 2; ++b)
#pragma unroll
                for (int m = 0; m < 4; ++m)
#pragma unroll
                    for (int n = 0; n < 2; ++n) acc[a][b][m][n] = (f32x4){0.f, 0.f, 0.f, 0.f};
        cur = nxt; cA = nA; cB = nB; ++ui;
        if constexpr (ALIGN_EPI) { if (wr == 1) PG8_BAR; }
    }
    PG8_WAIT_V(0);
    if constexpr (!ALIGN_EPI) { if (wr == 0) PG8_BAR; }
    PG8_BAR;
    if constexpr (Epi::AFTER_DRAIN) { E.fused(acc, cur, wr, wc, fr, fq, lds, wid, lane); S.done(cur); }
#undef PG8_SA
#undef PG8_SB
#undef PG8_STAGE
#undef PG8_LDA
#undef PG8_LDB
#undef PG8_MMA
#undef PG8_WAIT_V
#undef PG8_WAIT_L
#undef PG8_BAR
#undef PG8_SCHED
}
}
namespace att {
#define ATT_LAS __attribute__((address_space(3)))
typedef short bf16x8 __attribute__((ext_vector_type(8)));
typedef float f32x16 __attribute__((ext_vector_type(16)));
typedef float f32x4 __attribute__((ext_vector_type(4)));
typedef unsigned u32x4 __attribute__((ext_vector_type(4)));
typedef unsigned u32x2 __attribute__((ext_vector_type(2)));
typedef unsigned short bf16_t;
constexpr int KROW = 272, VROW = 136, KBYTES = 64 * KROW, VBYTES = 128 * VROW, BUF = KBYTES + VBYTES;
constexpr int KM_OFF = 2 * BUF;
constexpr int ATT_LDS = KM_OFF + 8192;
constexpr float NEG = -1.0e30f;
constexpr int SEQ = 4096, MROWS = 8192;
__device__ __forceinline__ int crow(int r, int hi) { return (r & 3) + 8 * (r >> 2) + 4 * hi; }
typedef float f32x2a_t __attribute__((ext_vector_type(2))); typedef __bf16 bf16x2a_t __attribute__((ext_vector_type(2)));
__device__ __forceinline__ unsigned cvtpk(float lo, float hi) { f32x2a_t v = {lo, hi}; bf16x2a_t b = __builtin_convertvector(v, bf16x2a_t); return __builtin_bit_cast(unsigned, b); }
#define ATT_MFMA(a, b, c) __builtin_amdgcn_mfma_f32_32x32x16_bf16((a), (b), (c), 0, 0, 0)

struct TileRegs { u32x4 k[2]; u32x4 v[2]; };
__device__ __forceinline__ void tile_load(TileRegs& t, const bf16_t* Kh, const bf16_t* Vth, int kv0, int tid) {
    const char* kt = (const char*)(Kh + (size_t)kv0 * 1024); const char* vt = (const char*)(Vth + kv0);
#pragma unroll
    for (int i = 0; i < 2; ++i) { const unsigned c = (unsigned)tid + 512u * i;
        t.k[i] = *(const u32x4*)(kt + (((c >> 4) * 1024u + (c & 15u) * 8u) * 2u));
        t.v[i] = *(const u32x4*)(vt + (((c >> 3) * (unsigned)MROWS + (c & 7u) * 8u) * 2u)); }
}
__device__ __forceinline__ void tile_store(const TileRegs& t, ATT_LAS unsigned char* buf, int tid) {
#pragma unroll
    for (int i = 0; i < 2; ++i) { const int c = tid + 512 * i;
        *(ATT_LAS u32x4*)(buf + (c >> 4) * KROW + (c & 15) * 16) = t.k[i];
        ATT_LAS u32x2* vp = (ATT_LAS u32x2*)(buf + KBYTES + (c >> 3) * VROW + (c & 7) * 16);
        vp[0] = (u32x2){t.v[i].x, t.v[i].y}; vp[1] = (u32x2){t.v[i].z, t.v[i].w}; }
}
__device__ __forceinline__ void softmax_step(f32x16& s, float& m, float& l, f32x16 (&o)[4]) {
    float mx = s[0];
#pragma unroll
    for (int r = 1; r < 16; ++r) mx = fmaxf(mx, s[r]);
    mx = fmaxf(mx, __shfl_xor(mx, 32));
    const float mn = fmaxf(m, mx);
    const float sc = __builtin_amdgcn_exp2f(m - mn);
    m = mn;
    float ps = 0.f;
#pragma unroll
    for (int r = 0; r < 16; ++r) { const float p = __builtin_amdgcn_exp2f(s[r] - mn); s[r] = p; ps += p; }
    l = l * sc + ps;
    if (__builtin_amdgcn_ballot_w64(sc != 1.0f) != 0ull) {
#pragma unroll
        for (int db = 0; db < 4; ++db)
#pragma unroll
            for (int r = 0; r < 16; ++r) o[db][r] *= sc;
    }
}
__device__ __forceinline__ bf16x8 pack8(const f32x16& p, int c) {
    u32x4 w; w.x = cvtpk(p[8 * c], p[8 * c + 1]); w.y = cvtpk(p[8 * c + 2], p[8 * c + 3]); w.z = cvtpk(p[8 * c + 4], p[8 * c + 5]); w.w = cvtpk(p[8 * c + 6], p[8 * c + 7]);
    return __builtin_bit_cast(bf16x8, w);
}
__device__ __forceinline__ bf16x8 vfrag(const ATT_LAS unsigned char* vb, int db, int sub, int c, int r32, int hi) {
    const ATT_LAS unsigned char* p = vb + (32 * db + r32) * VROW + (32 * sub + 16 * c + 4 * hi) * 2;
    const u32x2 lo = *(const ATT_LAS u32x2*)p, h2 = *(const ATT_LAS u32x2*)(p + 16);
    u32x4 w; w.x = lo.x; w.y = lo.y; w.z = h2.x; w.w = h2.y; return __builtin_bit_cast(bf16x8, w);
}

__device__ __forceinline__ void moba_unit(int b, int h, int qb, const bf16_t* QA, const bf16_t* KA, const bf16_t* VT, const float* kmean, bf16_t* YA, ATT_LAS unsigned char* lds) {
    int tid = threadIdx.x; asm volatile("" : "+v"(tid));
    const int lane = tid & 63, r32 = lane & 31, hi = lane >> 5, wid = __builtin_amdgcn_readfirstlane(tid >> 6);
    const bf16_t* Kh = KA + (size_t)b * SEQ * 1024 + h * 128;
    const bf16_t* Vth = VT + (size_t)(h * 128) * MROWS + (size_t)b * SEQ;
    const int qrow = b * SEQ + qb * 256 + wid * 32 + r32;
    __syncthreads();
    { ATT_LAS float* km = (ATT_LAS float*)(lds + KM_OFF); const float* src = kmean + (size_t)((b * 8 + h) * 16) * 128;
      for (int i = tid; i < 2048; i += 512) km[i] = src[i]; }
    bf16x8 qr[8];
#pragma unroll
    for (int st = 0; st < 8; ++st) qr[st] = *(const bf16x8*)(QA + (size_t)qrow * 1024 + h * 128 + st * 16 + hi * 8);
    TileRegs tr; tile_load(tr, Kh, Vth, 0, tid); tile_store(tr, lds, tid);
    __syncthreads();
    unsigned sel = 0u;
    if (qb > 0) {
        float v1 = -INFINITY, v2 = -INFINITY, v3 = -INFINITY; int i1 = 31, i2 = 31, i3 = 31;
        for (int j = 0; j < qb; ++j) {
            const ATT_LAS float* km = (const ATT_LAS float*)(lds + KM_OFF) + j * 128 + hi * 8;
            float dot = 0.f;
#pragma unroll
            for (int st = 0; st < 8; ++st) { const f32x4 k0 = *(const ATT_LAS f32x4*)(km + st * 16), k1 = *(const ATT_LAS f32x4*)(km + st * 16 + 4);
                const u32x4 qw = __builtin_bit_cast(u32x4, qr[st]);
                dot += __uint_as_float(qw.x << 16) * k0[0] + __uint_as_float(qw.x & 0xffff0000u) * k0[1] + __uint_as_float(qw.y << 16) * k0[2] + __uint_as_float(qw.y & 0xffff0000u) * k0[3]
                     + __uint_as_float(qw.z << 16) * k1[0] + __uint_as_float(qw.z & 0xffff0000u) * k1[1] + __uint_as_float(qw.w << 16) * k1[2] + __uint_as_float(qw.w & 0xffff0000u) * k1[3]; }
            dot += __shfl_xor(dot, 32);
            if (dot > v1) { v3 = v2; i3 = i2; v2 = v1; i2 = i1; v1 = dot; i1 = j; }
            else if (dot > v2) { v3 = v2; i3 = i2; v2 = dot; i2 = j; }
            else if (dot > v3) { v3 = dot; i3 = j; }
        }
        sel = (1u << i1) | (1u << i2) | (1u << i3);
    }
    f32x16 o[4];
#pragma unroll
    for (int db = 0; db < 4; ++db)
#pragma unroll
        for (int r = 0; r < 16; ++r) o[db][r] = 0.f;
    float m = NEG, l = 0.f;
    const int NS = 4 * (qb + 1), ql = wid * 32 + r32;
    for (int i = 0; i < NS; ++i) {
        const int j = i >> 2, t = i & 3;
        if (i + 1 < NS) tile_load(tr, Kh, Vth, (i + 1) * 64, tid);
        const ATT_LAS unsigned char* kb = lds + (i & 1) * BUF; const ATT_LAS unsigned char* vb = kb + KBYTES;
        const bool own = (j == qb);
        if (!own || t <= (wid >> 1)) {
            const bool lane_on = own || ((sel >> j) & 1u);
#pragma unroll 1
            for (int sub = 0; sub < 2; ++sub) {
                f32x16 s;
#pragma unroll
                for (int r = 0; r < 16; ++r) s[r] = 0.f;
#pragma unroll
                for (int st = 0; st < 8; ++st) { const bf16x8 a = *(const ATT_LAS bf16x8*)(kb + (32 * sub + r32) * KROW + (16 * st + 8 * hi) * 2); s = ATT_MFMA(a, qr[st], s); }
                if (own) {
#pragma unroll
                    for (int r = 0; r < 16; ++r) { const int kvl = 64 * t + 32 * sub + crow(r, hi); if (kvl > ql) s[r] = NEG; }
                } else {
#pragma unroll
                    for (int r = 0; r < 16; ++r) s[r] = lane_on ? s[r] : NEG;
                }
                softmax_step(s, m, l, o);
#pragma unroll
                for (int c = 0; c < 2; ++c) { const bf16x8 pb = pack8(s, c);
#pragma unroll
                    for (int db = 0; db < 4; ++db) o[db] = ATT_MFMA(vfrag(vb, db, sub, c, r32, hi), pb, o[db]); }
            }
        }
        if (i + 1 < NS) tile_store(tr, lds + ((i + 1) & 1) * BUF, tid);
        __syncthreads();
    }
    l += __shfl_xor(l, 32);
    const float inv = 1.0f / l;
    bf16_t* yp = YA + (size_t)qrow * 1024 + h * 128 + 4 * hi;
#pragma unroll
    for (int db = 0; db < 4; ++db)
#pragma unroll
        for (int g = 0; g < 4; ++g) { u32x2 w; w.x = cvtpk(o[db][4 * g] * inv, o[db][4 * g + 1] * inv); w.y = cvtpk(o[db][4 * g + 2] * inv, o[db][4 * g + 3] * inv);
            *(u32x2*)(yp + 32 * db + 8 * g) = w; }
}

__device__ __forceinline__ void diff_unit(int b, int h, int qi, const bf16_t* QB, const bf16_t* KB, const bf16_t* VT, const float* subln_w, float lam, float out_scale, float* SCR, bf16_t* YB, ATT_LAS unsigned char* lds) {
    const bf16_t* Kh = KB + (size_t)b * SEQ * 1024 + h * 128;
    const bf16_t* Vth = VT + (size_t)(1024 + h * 128) * MROWS + (size_t)b * SEQ;
    const int NS = 4 * (qi + 1);
#pragma unroll 1
    for (int pass = 0; pass < 2; ++pass) {
        int tid = threadIdx.x; asm volatile("" : "+v"(tid));
        const int lane = tid & 63, r32 = lane & 31, hi = lane >> 5, wid = __builtin_amdgcn_readfirstlane(tid >> 6);
        const int qrow = b * SEQ + qi * 256 + wid * 32 + r32, ql = wid * 32 + r32;
        const int koff = pass * 64;
        __syncthreads();
        bf16x8 q[4];
#pragma unroll
        for (int st = 0; st < 4; ++st) q[st] = *(const bf16x8*)(QB + (size_t)qrow * 1024 + h * 128 + koff + st * 16 + hi * 8);
        TileRegs tr; tile_load(tr, Kh, Vth, 0, tid); tile_store(tr, lds, tid);
        __syncthreads();
        f32x16 o[4];
#pragma unroll
        for (int db = 0; db < 4; ++db)
#pragma unroll
            for (int r = 0; r < 16; ++r) o[db][r] = 0.f;
        float m = NEG, l = 0.f;
#pragma unroll 1
        for (int i = 0; i < NS; ++i) {
            if (i + 1 < NS) tile_load(tr, Kh, Vth, (i + 1) * 64, tid);
            const ATT_LAS unsigned char* kb = lds + (i & 1) * BUF; const ATT_LAS unsigned char* vb = kb + KBYTES;
            const int t = i - 4 * qi;
            if (t < 0 || t <= (wid >> 1)) {
#pragma unroll 1
                for (int sub = 0; sub < 2; ++sub) {
                    f32x16 s;
#pragma unroll
                    for (int r = 0; r < 16; ++r) s[r] = 0.f;
#pragma unroll
                    for (int st = 0; st < 4; ++st) s = ATT_MFMA(*(const ATT_LAS bf16x8*)(kb + (32 * sub + r32) * KROW + (koff + 16 * st + 8 * hi) * 2), q[st], s);
                    if (t >= 0) {
#pragma unroll
                        for (int r = 0; r < 16; ++r) { const int kvl = 64 * t + 32 * sub + crow(r, hi); if (kvl > ql) s[r] = NEG; }
                    }
                    softmax_step(s, m, l, o);
#pragma unroll
                    for (int c = 0; c < 2; ++c) { const bf16x8 pb = pack8(s, c);
#pragma unroll
                        for (int db = 0; db < 4; ++db) o[db] = ATT_MFMA(vfrag(vb, db, sub, c, r32, hi), pb, o[db]); }
                }
            }
            if (i + 1 < NS) tile_store(tr, lds + ((i + 1) & 1) * BUF, tid);
            __syncthreads();
        }
        l += __shfl_xor(l, 32);
        float* sp = SCR + (size_t)qrow * 1024 + h * 128 + 4 * hi;
        if (pass == 0) {
            const float inv = 1.0f / l;
#pragma unroll
            for (int db = 0; db < 4; ++db)
#pragma unroll
                for (int g = 0; g < 4; ++g) *(f32x4*)(sp + 32 * db + 8 * g) = (f32x4){o[db][4 * g] * inv, o[db][4 * g + 1] * inv, o[db][4 * g + 2] * inv, o[db][4 * g + 3] * inv};
        } else {
            const float i2 = lam / l;
            float ss = 0.f;
#pragma unroll
            for (int db = 0; db < 4; ++db)
#pragma unroll
                for (int g = 0; g < 4; ++g) { const f32x4 a = *(const f32x4*)(sp + 32 * db + 8 * g);
#pragma unroll
                    for (int k = 0; k < 4; ++k) { const float v = a[k] - o[db][4 * g + k] * i2; o[db][4 * g + k] = v; ss += v * v; }
                    if (g & 1) asm volatile("" ::: "memory"); }
            ss += __shfl_xor(ss, 32);
            const float rs = out_scale / sqrtf(ss * (1.0f / 128.0f) + 1e-5f);
            bf16_t* yp = YB + (size_t)qrow * 1024 + h * 128 + 4 * hi;
#pragma unroll
            for (int db = 0; db < 4; ++db)
#pragma unroll
                for (int g = 0; g < 4; ++g) { const f32x4 w4 = *(const f32x4*)(subln_w + 32 * db + 8 * g + 4 * hi);
                    u32x2 w; w.x = cvtpk(o[db][4 * g] * rs * w4[0], o[db][4 * g + 1] * rs * w4[1]); w.y = cvtpk(o[db][4 * g + 2] * rs * w4[2], o[db][4 * g + 3] * rs * w4[3]);
                    *(u32x2*)(yp + 32 * db + 8 * g) = w;
                    if (g & 1) asm volatile("" ::: "memory"); }
        }
    }
}
}
namespace cg = cooperative_groups;
#ifndef MK_N_LAUNCHES
#define MK_N_LAUNCHES 9
#define MK_DUMP 0
#define MK_DUMP_PH 2
#define MK_DUMP_OFF (WS_R2 + 64 * MiB)
#endif
constexpr int NPHASE = 9;
#ifndef MK_REPS
#define MK_REPS 1
#endif
constexpr int NWAVES = 8;
constexpr int M = 8192, DM = 2048, SEQ = 4096, NIN = 8192  , FFH = 5632;
constexpr float LN_EPS = 1e-5f;
constexpr float ALPHA = 1.189207115002721f;
constexpr float SC_A = 0.08838834764831845f * 1.4426950408889634f, SC_B = 0.125f * 1.4426950408889634f;
constexpr float LAM_INIT = 0.2f;

constexpr size_t MiB = 1u << 20;
constexpr size_t WS_WIN = 1 * MiB, WS_WV = 33 * MiB, WS_WBA = 41 * MiB, WS_WBB = 45 * MiB, WS_WOUT = 49 * MiB, WS_WFI = 57 * MiB, WS_WFO = 101 * MiB;
constexpr size_t WS_T128 = 123 * MiB, WS_T64 = 125 * MiB, WS_KM = 126 * MiB;
constexpr size_t WS_R1 = 128 * MiB;
constexpr size_t WS_R2 = 160 * MiB;
constexpr size_t WS_R3 = 288 * MiB;
constexpr size_t WS_END = 320 * MiB;
constexpr int MISC_OFF = 131072, LDS_BYTES = 131072 + 1024;
constexpr size_t WS_CTL = 0, CTL_ZERO_BYTES = 65536;

#define LAS __attribute__((address_space(3)))
typedef unsigned short bf16;
typedef unsigned v4u __attribute__((ext_vector_type(4)));
typedef unsigned v2u __attribute__((ext_vector_type(2)));
typedef float f32x4 __attribute__((ext_vector_type(4)));
__device__ __forceinline__ unsigned f2bf(float f) { unsigned u = __builtin_bit_cast(unsigned, f); return (u + 0x7fffu + ((u >> 16) & 1u)) >> 16; }
__device__ __forceinline__ unsigned pk2(float lo, float hi) { return f2bf(lo) | (f2bf(hi) << 16); }
__device__ __forceinline__ float wave_sum(float v) {
#pragma unroll
    for (int o = 1; o < 64; o <<= 1) v += __shfl_xor(v, o);
    return v;
}
#define XB_TMO      128
#define XB_XCNT(j)  (256  + 64 * (j))
#define XB_XSUB(j)  (1280 + 64 * (j))
#define XB_XGEN(j)  (2304 + 64 * (j))
#define XB_TOP      3328
#define XB_TOPGEN   3392
#define XCD_BAR_WORDS 3456
#define XB_SPIN_CAP (1u << 18)

__device__ __forceinline__ unsigned xb_ld(unsigned* p)              { return __hip_atomic_load(p, __ATOMIC_RELAXED, __HIP_MEMORY_SCOPE_AGENT); }
__device__ __forceinline__ unsigned xb_add(unsigned* p, unsigned v) { return __hip_atomic_fetch_add(p, v, __ATOMIC_RELAXED, __HIP_MEMORY_SCOPE_AGENT); }
__device__ __forceinline__ unsigned xb_xcc_id() { return (unsigned)__builtin_amdgcn_s_getreg((3 << 11) | 20) & 0xFu; }
#define XB_SPIN(cond, bar) do { unsigned _sp = 0; while (cond) { __builtin_amdgcn_s_sleep(1); \
    if ((++_sp & 255u) == 0u) { if (xb_ld(&(bar)[XB_TMO])) break; if (_sp > XB_SPIN_CAP) { atomicAdd(&(bar)[XB_TMO], 1u); break; } } } } while (0)

struct XcdBarrier {
    unsigned* bar; unsigned x;
    volatile LAS unsigned* st;
};

__device__ __forceinline__ XcdBarrier xcd_barrier_post(unsigned* bar, volatile LAS unsigned* st) {
    XcdBarrier b; b.bar = bar; b.x = xb_xcc_id(); b.st = st;
    if (threadIdx.x == 0) (void)xb_add(&bar[XB_XCNT(b.x)], 1u);
    return b;
}
__device__ __forceinline__ void xcd_barrier_complete(unsigned* bar, unsigned x, unsigned& nloc, unsigned& nx) {
    const unsigned G = gridDim.x * gridDim.y * gridDim.z;
    unsigned sum, cnt, mine, sp = 0u;
    for (;;) {
        sum = 0u; cnt = 0u; mine = 0u;
#pragma unroll
        for (unsigned j = 0; j < 16; ++j) { const unsigned c = xb_ld(&bar[XB_XCNT(j)]); sum += c; cnt += (c > 0u) ? 1u : 0u; mine = (j == x) ? c : mine; }
        if (sum == G) break;
        __builtin_amdgcn_s_sleep(1);
        if ((++sp & 255u) == 0u) { if (xb_ld(&bar[XB_TMO])) break; if (sp > XB_SPIN_CAP) { atomicAdd(&bar[XB_TMO], 1u); break; } }
    }
    nloc = mine > 0u ? mine : 1u; nx = cnt > 0u ? cnt : 1u;
}

__device__ __forceinline__ void xcd_barrier(const XcdBarrier& b) {
    asm volatile("s_waitcnt vmcnt(0)" ::: "memory");
    __syncthreads();
    if (threadIdx.x == 0) {
        unsigned* bar = b.bar;
        __builtin_amdgcn_s_waitcnt(0);
        unsigned nloc = b.st[0], nx = b.st[1];
        if (nloc == 0u) { xcd_barrier_complete(bar, b.x, nloc, nx); b.st[0] = nloc; b.st[1] = nx; }
        const unsigned old = xb_add(&bar[XB_XSUB(b.x)], 1u);
        const unsigned gen = old / nloc;
        if (old + 1u == (gen + 1u) * nloc) {
            __builtin_amdgcn_fence(__ATOMIC_RELEASE, "agent");
            asm volatile("s_waitcnt vmcnt(0)" ::: "memory");
            const unsigned og = xb_add(&bar[XB_TOP], 1u);
            const unsigned tg = og / nx;
            if (og + 1u == (tg + 1u) * nx) xb_add(&bar[XB_TOPGEN], 1u);
            else XB_SPIN(xb_ld(&bar[XB_TOPGEN]) == tg, bar);
            __builtin_amdgcn_fence(__ATOMIC_ACQUIRE, "agent");
            xb_add(&bar[XB_XGEN(b.x)], 1u);
            asm volatile("s_waitcnt vmcnt(0)" ::: "memory");
        } else {
            XB_SPIN(xb_ld(&bar[XB_XGEN(b.x)]) == gen, bar);
            __builtin_amdgcn_fence(__ATOMIC_ACQUIRE, "agent");
            asm volatile("s_waitcnt vmcnt(0)" ::: "memory");
        }
    }
    __syncthreads();
}
__device__ __forceinline__ int src_col_in(int g) {
    if (g >= 4096) return g + 2048;
    const int region = g >> 10, h = (g >> 7) & 7, gl = g & 127, e = gl & 7, blk = gl >> 3;
    const int base = region == 0 ? 0 : region == 1 ? 1024 : region == 2 ? 3072 : 4096;
    const int d = region < 2 ? 4 * blk + (e & 3) + 64 * (e >> 2) : (blk >> 3) * 64 + 4 * (blk & 7) + (e & 3) + 32 * (e >> 2);
    return base + h * 128 + d;
}
__device__ __forceinline__ void p0_item(const float* W, int K, int N, int Ndst, bf16* WT, LAS float* scr, int item, int lane, int mode, int src_off) {
    const int nblk = Ndst / 32, kb = item / nblk, nb = item % nblk, k0 = 64 * kb, g0 = 32 * nb;
    const int g = g0 + (lane & 31);
    const int sc = mode == 0 ? src_off + g : (mode == 1 ? src_col_in(g) : ((g >> 7) & 1) * 5632 + 128 * (g >> 8) + (g & 127));
#pragma unroll 8
    for (int i = 0; i < 32; ++i) { const int kk = 2 * i + (lane >> 5); scr[kk * 33 + (lane & 31)] = W[(size_t)(k0 + kk) * N + sc]; }
    asm volatile("s_waitcnt lgkmcnt(0)" ::: "memory");
    const int c = lane & 7;
#pragma unroll
    for (int j = 0; j < 4; ++j) { const int n = (lane >> 3) + 8 * j; const LAS float* s = scr + (8 * c) * 33 + n;
        v4u o; o.x = pk2(s[0 * 33], s[1 * 33]); o.y = pk2(s[2 * 33], s[3 * 33]); o.z = pk2(s[4 * 33], s[5 * 33]); o.w = pk2(s[6 * 33], s[7 * 33]);
        *(v4u*)(WT + (size_t)(g0 + n) * K + k0 + 8 * c) = o; }
    asm volatile("s_waitcnt lgkmcnt(0)" ::: "memory");
}
__device__ __forceinline__ void ln_row(float* row, const float* gam, const float* bet, bf16* brow, int lane) {
    f32x4* xr = (f32x4*)row + lane; f32x4 v[8]; float s = 0.f;
#pragma unroll
    for (int j = 0; j < 8; ++j) { v[j] = xr[64 * j]; s += (v[j].x + v[j].y) + (v[j].z + v[j].w); }
    const float mean = wave_sum(s) * (1.f / 2048.f); float s2 = 0.f;
#pragma unroll
    for (int j = 0; j < 8; ++j) { v[j] = v[j] - mean; s2 += (v[j].x * v[j].x + v[j].y * v[j].y) + (v[j].z * v[j].z + v[j].w * v[j].w); }
    const float rstd = 1.f / sqrtf(wave_sum(s2) * (1.f / 2048.f) + LN_EPS);
#pragma unroll
    for (int j = 0; j < 8; ++j) { const f32x4 g4 = *((const f32x4*)gam + 64 * j + lane), b4 = *((const f32x4*)bet + 64 * j + lane);
        const f32x4 o = v[j] * rstd * g4 + b4; xr[64 * j] = o;
        if (brow) { v2u w; w.x = pk2(o.x, o.y); w.y = pk2(o.z, o.w); *((v2u*)brow + 64 * j + lane) = w; } }
}

struct Args { const float* in[13]; float* out; unsigned char* ws; int ph_lo, ph_hi, coop, pad; };
__global__ void __launch_bounds__(NWAVES * 64, 2) mk_fwd(Args args) {
    extern __shared__ __attribute__((aligned(16))) unsigned char lds_raw[];
    LAS unsigned char* lds = (LAS unsigned char*)lds_raw;
    const int wave = __builtin_amdgcn_readfirstlane(threadIdx.x >> 6);
    const int G = gridDim.x, bx = blockIdx.x, vcu = (G % 8 == 0) ? (bx % 8) * (G / 8) + bx / 8 : bx;
    unsigned char* ws = args.ws;
    const float* x = args.in[0]; const float* w_in = args.in[1]; const float* lambda_qk = args.in[2]; const float* subln_w = args.in[3];
    const float* w_ba = args.in[4]; const float* w_bb = args.in[5]; const float* w_out = args.in[6]; const float* ln1_g = args.in[7]; const float* ln1_b = args.in[8];
    const float* w_fi = args.in[9]; const float* w_fo = args.in[10]; const float* ln2_g = args.in[11]; const float* ln2_b = args.in[12];
    float* out = args.out;
    bf16* WinT = (bf16*)(ws + WS_WIN); bf16* WvT = (bf16*)(ws + WS_WV); bf16* WbaT = (bf16*)(ws + WS_WBA); bf16* WbbT = (bf16*)(ws + WS_WBB);
    bf16* WoutT = (bf16*)(ws + WS_WOUT); bf16* WfiT = (bf16*)(ws + WS_WFI); bf16* WfoT = (bf16*)(ws + WS_WFO);
    float* T128 = (float*)(ws + WS_T128); float* T64 = (float*)(ws + WS_T64); float* kmean = (float*)(ws + WS_KM);
    bf16* XB = (bf16*)(ws + WS_R1); bf16* YA = (bf16*)(ws + WS_R1); bf16* YB = YA + (size_t)M * 1024; bf16* H1B = (bf16*)(ws + WS_R1);
    bf16* QK = (bf16*)(ws + WS_R2); bf16* SG = QK + (size_t)4 * M * 1024; bf16* HID = (bf16*)(ws + WS_R2);
    bf16* VT = (bf16*)(ws + WS_R3); bf16* MB = (bf16*)(ws + WS_R3);
    const int lo = args.ph_lo, hi = args.ph_hi;
#ifdef ONLY_PHASE
#define IN(k) ((k) == ONLY_PHASE && lo <= (k) && (k) < hi)
#else
#define IN(k) (lo <= (k) && (k) < hi)
#endif
#define SEAM(k) do { if (args.coop && IN(k) && IN((k) + 1)) xcd_barrier(bar); } while (0)
    const int gw = vcu * NWAVES + wave, NGW = G * NWAVES, NGT = G * NWAVES * 64;
    volatile LAS unsigned* MISC = (volatile LAS unsigned*)(lds + MISC_OFF);
    if (threadIdx.x < 32) MISC[threadIdx.x] = 0u;
    __syncthreads();
    XcdBarrier bar; bar.bar = (unsigned*)(ws + WS_CTL); bar.x = 0; bar.st = nullptr;
    if (args.coop) bar = xcd_barrier_post((unsigned*)(ws + WS_CTL), MISC + 8);
    if (args.pad == 0x5a5a) cg::this_grid().sync();

    if (IN(0)) {
        const int tid = threadIdx.x, lane = tid & 63, gt = bx * (NWAVES * 64) + tid;
        LAS float* scr = (LAS float*)(lds + wave * 16384);
        constexpr int I_IN = (DM / 64) * (NIN / 32), I_V = (DM / 64) * (2048 / 32), I_BA = (1024 / 64) * (2048 / 32), I_OUT = (DM / 64) * (2048 / 32), I_FI = (DM / 64) * (2 * FFH / 32), I_FO = (FFH / 64) * (2048 / 32);
        constexpr int NITEMS = I_IN + I_V + 2 * I_BA + I_OUT + I_FI + I_FO;
        for (int it = gw; it < NITEMS; it += NGW) {
            int r = it;
            if (r < I_IN) { p0_item(w_in, DM, 10240, NIN, WinT, scr, r, lane, 1, 0); continue; } r -= I_IN;
            if (r < I_V) { const int nblk = 2048 / 32, nb = r % nblk; p0_item(w_in, DM, 10240, 2048, WvT, scr, r, lane, 0, nb < 32 ? 2048 : 5120 - 1024); continue; } r -= I_V;
            if (r < I_BA) { p0_item(w_ba, 1024, 2048, 2048, WbaT, scr, r, lane, 0, 0); continue; } r -= I_BA;
            if (r < I_BA) { p0_item(w_bb, 1024, 2048, 2048, WbbT, scr, r, lane, 0, 0); continue; } r -= I_BA;
            if (r < I_OUT) { p0_item(w_out, DM, 2048, 2048, WoutT, scr, r, lane, 0, 0); continue; } r -= I_OUT;
            if (r < I_FI) { p0_item(w_fi, DM, 2 * FFH, 2 * FFH, WfiT, scr, r, lane, 2, 0); continue; } r -= I_FI;
            p0_item(w_fo, FFH, 2048, 2048, WfoT, scr, r, lane, 0, 0);
        }
        for (int i = gt; i < M * DM / 8; i += NGT) { const f32x4 a = *((const f32x4*)x + 2 * (size_t)i), b = *((const f32x4*)x + 2 * (size_t)i + 1);
            v4u o; o.x = pk2(a.x, a.y); o.y = pk2(a.z, a.w); o.z = pk2(b.x, b.y); o.w = pk2(b.z, b.w); *((v4u*)XB + i) = o; }
        for (int i = gt; i < SEQ * 96; i += NGT) {
            int pos, f, half; float* tab;
            if (i < SEQ * 64) { pos = i >> 6; f = i & 63; half = 64; tab = T128; } else { const int k = i - SEQ * 64; pos = k >> 5; f = k & 31; half = 32; tab = T64; }
            const float inv_freq = (float)exp2(-(double)f / (double)half * 13.287712379549449);
            const float ang = (float)pos * inv_freq;
            double tt = (double)ang * 0.15915494309189535; tt -= floor(tt);
            tab[(size_t)pos * half + f] = __builtin_amdgcn_cosf((float)tt); tab[(size_t)(SEQ + pos) * half + f] = __builtin_amdgcn_sinf((float)tt);
        }
        for (int i = gt; i < 2 * 8 * 16 * 128; i += NGT) kmean[i] = 0.f;
    }
    SEAM(0);
    if (IN(1)) {
        { pg8::Gemm g{XB, WinT, M, NIN, DM}; pg8::StaticOrder S; S.init(M, NIN, G, bx);
          pg8::EpiIn E{QK, SG, T128, T64, kmean, SC_A, SC_B};
          pg8::gemm_phase<pg8::EpiIn, pg8::StaticOrder, true, true>(lds, g, S, E); }
        { pg8::Gemm g{WvT, XB, 2048, M, DM}; pg8::StaticOrder S; S.init(2048, M, G, bx);
          pg8::EpiStore E{VT, M};
          pg8::gemm_phase<pg8::EpiStore, pg8::StaticOrder, true, true>(lds, g, S, E); }
    }
    SEAM(1);
    if (IN(2)) {
        const int lane = threadIdx.x & 63;
        float sa = 0.f, sb = 0.f;
        { const float a = lambda_qk[lane] * lambda_qk[64 + lane], b = lambda_qk[128 + lane] * lambda_qk[192 + lane]; sa = wave_sum(a); sb = wave_sum(b); }
        const float lam = expf(sa) - expf(sb) + LAM_INIT;
        for (int u = vcu; u < 256; u += G) {
            const int b = u >> 7, h = (u >> 4) & 7, xq = u & 15;
#ifndef NO_MOBA
            att::moba_unit(b, h, xq, QK, QK + (size_t)M * 1024, VT, kmean, YA, lds);
#endif
#ifndef NO_DIFF
            att::diff_unit(b, h, 15 - xq, QK + (size_t)2 * M * 1024, QK + (size_t)3 * M * 1024, VT, subln_w, lam, 1.0f - LAM_INIT, out, YB, lds);
#endif
        }
        __syncthreads();
    }
    SEAM(2);
    if (IN(3)) {
        { pg8::Gemm g{YA, WbaT, M, DM, 1024}; pg8::StaticOrder S; S.init(M, DM, G, bx);
          pg8::EpiBrA E{out, SG};
          pg8::gemm_phase<pg8::EpiBrA, pg8::StaticOrder, true, true>(lds, g, S, E); }
        { pg8::Gemm g{YB, WbbT, M, DM, 1024}; pg8::StaticOrder S; S.init(M, DM, G, bx);
          pg8::EpiBrB E{out, SG, MB};
          pg8::gemm_phase<pg8::EpiBrB, pg8::StaticOrder, true, true>(lds, g, S, E); }
    }
    SEAM(3);
    if (IN(4)) {
        pg8::Gemm g{MB, WoutT, M, DM, DM}; pg8::StaticOrder S; S.init(M, DM, G, bx);
        pg8::EpiRes E{x, out, ALPHA};
        pg8::gemm_phase<pg8::EpiRes, pg8::StaticOrder, true, true>(lds, g, S, E);
    }
    SEAM(4);
    if (IN(5)) { const int lane = threadIdx.x & 63; for (int m = gw; m < M; m += NGW) ln_row(out + (size_t)m * DM, ln1_g, ln1_b, H1B + (size_t)m * DM, lane); }
    SEAM(5);
    if (IN(6)) {
        pg8::Gemm g{H1B, WfiT, M, 2 * FFH, DM}; pg8::StaticOrder S; S.init(M, 2 * FFH, G, bx);
        pg8::EpiSwiglu E{HID};
        pg8::gemm_phase<pg8::EpiSwiglu, pg8::StaticOrder, true, true>(lds, g, S, E);
    }
    SEAM(6);
    if (IN(7)) {
        pg8::Gemm g{HID, WfoT, M, DM, FFH}; pg8::StaticOrder S; S.init(M, DM, G, bx);
        pg8::EpiRes E{out, out, ALPHA};
        pg8::gemm_phase<pg8::EpiRes, pg8::StaticOrder, true, true>(lds, g, S, E);
    }
    SEAM(7);
    if (IN(8)) { const int lane = threadIdx.x & 63; for (int m = gw; m < M; m += NGW) ln_row(out + (size_t)m * DM, ln2_g, ln2_b, nullptr, lane); }
#undef IN
#undef SEAM
}

__global__ void dump_sum4(const unsigned short* a, const unsigned short* b, const unsigned short* c, const unsigned short* d, float* out, int n) {
    for (int i = blockIdx.x * blockDim.x + threadIdx.x; i < n; i += gridDim.x * blockDim.x)
        out[i] = __uint_as_float((unsigned)a[i] << 16) + __uint_as_float((unsigned)b[i] << 16) + __uint_as_float((unsigned)c[i & (2097152 - 1)] << 16) + __uint_as_float((unsigned)d[i & (2097152 - 1)] << 16); }
__global__ void dump_bf16(const unsigned short* src, float* out, int n) { for (int i = blockIdx.x * blockDim.x + threadIdx.x; i < n; i += gridDim.x * blockDim.x) out[i] = __uint_as_float((unsigned)src[i] << 16); }
#ifndef MK_DUMP
#define MK_DUMP 0
#endif
#ifndef MK_DUMP_PH
#define MK_DUMP_PH 3
#define MK_DUMP_OFF WS_R1
#endif
extern "C" void kernel_launch(void* const* d_in, const int* in_sizes, int n_in, void* d_out, int out_size, void* d_ws, size_t ws_size, hipStream_t stream) {
    static int grid = 0;
    if (grid == 0) {
        if (n_in != 13 || in_sizes[0] != M * DM || out_size != M * DM || ws_size < WS_END) { fprintf(stderr, "kernel_launch: unexpected shapes (n_in %d, in0 %d, out %d, ws %zu); nothing launched\n", n_in, n_in > 0 ? in_sizes[0] : -1, out_size, ws_size); grid = -1; return; }
        int dev = 0, cus = 0, per_cu = 0;
        if (hipGetDevice(&dev) != hipSuccess || hipDeviceGetAttribute(&cus, hipDeviceAttributeMultiprocessorCount, dev) != hipSuccess) { grid = -1; return; }
        if (hipFuncSetAttribute((const void*)mk_fwd, hipFuncAttributeMaxDynamicSharedMemorySize, LDS_BYTES) != hipSuccess) { fprintf(stderr, "kernel_launch: hipFuncSetAttribute failed\n"); grid = -1; return; }
        if (hipOccupancyMaxActiveBlocksPerMultiprocessor(&per_cu, (const void*)mk_fwd, NWAVES * 64, LDS_BYTES) != hipSuccess || per_cu < 1) { fprintf(stderr, "kernel_launch: occupancy query gave %d\n", per_cu); per_cu = 1; }
        (void)hipGetLastError();
        grid = cus * per_cu; if (grid > 256) grid = 256;
        grid -= grid % 8; if (grid < 8) grid = 8;
    }
    if (grid < 0) return;
    if (hipMemsetAsync((char*)d_ws + WS_CTL, 0, CTL_ZERO_BYTES, stream) != hipSuccess) { fprintf(stderr, "kernel_launch: hipMemsetAsync failed\n"); return; }
    Args a{};
    for (int i = 0; i < 13; ++i) a.in[i] = (const float*)d_in[i];
    a.out = (float*)d_out; a.ws = (unsigned char*)d_ws;
    if (MK_N_LAUNCHES == 1) {
        a.ph_lo = 0; a.ph_hi = NPHASE; a.coop = 1;
        void* kargs[] = {&a};
        const hipError_t e = hipLaunchCooperativeKernel((const void*)mk_fwd, dim3(grid), dim3(NWAVES * 64), kargs, LDS_BYTES, stream);
        if (e != hipSuccess) fprintf(stderr, "kernel_launch: cooperative launch failed: %s (grid %d)\n", hipGetErrorString(e), grid);
    } else {
        const int lastp = MK_DUMP == 0 ? NPHASE : MK_DUMP_PH;
        for (int rep = 0; rep < MK_REPS; ++rep) for (int p = 0; p < lastp; ++p) { a.ph_lo = p; a.ph_hi = p + 1; a.coop = 0;
            hipLaunchKernelGGL(mk_fwd, dim3(grid), dim3(NWAVES * 64), LDS_BYTES, stream, a); }
        if (MK_DUMP == 2) { hipLaunchKernelGGL(dump_sum4, dim3(2048), dim3(256), 0, stream, (const unsigned short*)((const char*)d_ws + WS_R2 + 64 * MiB), (const unsigned short*)((const char*)d_ws + WS_R2 + 96 * MiB),
            (const unsigned short*)((const char*)d_ws + WS_WBA), (const unsigned short*)((const char*)d_ws + WS_WBB), (float*)d_out, M * DM); }
        else if (MK_DUMP) { hipLaunchKernelGGL(dump_bf16, dim3(2048), dim3(256), 0, stream, (const unsigned short*)((const char*)d_ws + MK_DUMP_OFF), (float*)d_out, M * DM); }
    }
}
```

```cpp
#include <hip/hip_runtime.h>
#include <hip/hip_cooperative_groups.h>
#include <cstdio>
#include <cstdint>
#include <cmath>
namespace pg8 {
#define PG8_LAS __attribute__((address_space(3)))
typedef unsigned short bf16_t;
typedef short bf16x8 __attribute__((ext_vector_type(8)));
typedef float f32x4 __attribute__((ext_vector_type(4)));
typedef unsigned u32x4 __attribute__((ext_vector_type(4)));
constexpr int BM = 256, BK = 64, HALF = 128, HTB = HALF * BK * 2  , STAGE_BYTES = 8 * HTB, NXCD = 8, WGM = 8;

__host__ __device__ __forceinline__ int lds_byte(int r, int c) { const int st = (r >> 4) * 2 + (c >> 5), rr = r & 15, cc = c & 31, ob = rr * 64 + cc * 2; return st * 1024 + (ob ^ (((ob >> 9) & 1) << 5)); }
__host__ __device__ __forceinline__ void stage_rc(int b, int& R, int& C) { const int st = b / 1024, sb = b % 1024, swz = sb ^ (((sb >> 9) & 1) << 5); R = (st >> 1) * 16 + swz / 64; C = (st & 1) * 32 + (swz % 64) / 2; }
__host__ __device__ __forceinline__ int perm32(int rho) { const int n = rho >> 4, i = rho & 15; return 8 * (i >> 2) + 4 * n + (i & 3); }

struct Unit { int pm, pn; };
struct Gemm { const bf16_t* A; const bf16_t* Bt; int M, N, K; };

struct StaticOrder {
    int nM, nN, nwg, G, c;
    __host__ __device__ void init(int M, int N, int G_, int c_) { nM = M / BM; nN = N / BM; nwg = nM * nN; G = G_; c = c_; }
    __host__ __device__ bool next(int i, Unit& u) const {
        const long L = (long)i * G + c; if (L >= nwg) return false;
        int wgid = (int)L; { const int q = nwg / NXCD, r = nwg % NXCD, xcd = wgid % NXCD, off = wgid / NXCD; wgid = (xcd < r ? xcd * (q + 1) : r * (q + 1) + (xcd - r) * q) + off; }
        const int nig = WGM * nN, gid = wgid / nig, fm = gid * WGM, gsz = (nM - fm) < WGM ? (nM - fm) : WGM;
        u.pm = fm + ((wgid % nig) % gsz); u.pn = (wgid % nig) / gsz; return true;
    }
    __device__ __forceinline__ void a_ready(const Unit&) const {}
    __device__ __forceinline__ void done(const Unit&) const {}
};

typedef float f32x2c_t __attribute__((ext_vector_type(2))); typedef __bf16 bf16x2c_t __attribute__((ext_vector_type(2)));
__device__ __forceinline__ unsigned cvt_pk_bf16(float lo, float hi) { f32x2c_t v = {lo, hi}; bf16x2c_t b = __builtin_convertvector(v, bf16x2c_t); return __builtin_bit_cast(unsigned, b); }
typedef float f32x2 __attribute__((ext_vector_type(2)));
typedef unsigned u32x2 __attribute__((ext_vector_type(2)));
__device__ __forceinline__ float fast_sigmoid(float v) { return __builtin_amdgcn_rcpf(1.0f + __builtin_amdgcn_exp2f(-1.4426950408889634f * v)); }
__device__ __forceinline__ float bf_lo(unsigned w) { return __uint_as_float(w << 16); }
__device__ __forceinline__ float bf_hi(unsigned w) { return __uint_as_float(w & 0xffff0000u); }

struct EpiStore {
    static constexpr bool PERM = true, AFTER_DRAIN = false;
    bf16_t* O; int ldc;
    __device__ __forceinline__ void operator()(const f32x4 (&acc)[2][2][4][2], const Unit& u, int wr, int wc, int fr, int fq) const {
        const int row0 = u.pm * BM + wr * 64 + fr, col0 = u.pn * BM + wc * 32 + 8 * fq;
#pragma unroll
        for (int ai = 0; ai < 2; ++ai)
#pragma unroll
            for (int m = 0; m < 4; ++m) { bf16_t* rowp = O + (size_t)(row0 + ai * HALF + m * 16) * ldc + col0;
#pragma unroll
                for (int bj = 0; bj < 2; ++bj) { const f32x4 v0 = acc[ai][bj][m][0], v1 = acc[ai][bj][m][1];
                    u32x4 w; w.x = cvt_pk_bf16(v0[0], v0[1]); w.y = cvt_pk_bf16(v0[2], v0[3]); w.z = cvt_pk_bf16(v1[0], v1[1]); w.w = cvt_pk_bf16(v1[2], v1[3]);
                    *(u32x4*)(rowp + bj * HALF) = w; } }
    }
};

struct EpiIn {
    static constexpr bool PERM = true, AFTER_DRAIN = false;
    bf16_t* QK;
    bf16_t* SG;
    const float* T128;
    const float* T64;
    float* kmean;
    float scA, scB;
    __device__ __forceinline__ void operator()(const f32x4 (&acc)[2][2][4][2], const Unit& u, int wr, int wc, int fr, int fq) const {
        const int pn = u.pn, row0 = u.pm * BM + wr * 64 + fr;
        if (pn >= 16) {
            const int col0 = (pn - 16) * BM + wc * 32 + 8 * fq;
#pragma unroll
            for (int ai = 0; ai < 2; ++ai)
#pragma unroll
                for (int m = 0; m < 4; ++m) { bf16_t* rowp = SG + (size_t)(row0 + ai * HALF + m * 16) * 4096 + col0;
#pragma unroll
                    for (int bj = 0; bj < 2; ++bj) { const f32x4 v0 = acc[ai][bj][m][0], v1 = acc[ai][bj][m][1];
                        u32x4 w; w.x = cvt_pk_bf16(fast_sigmoid(v0[0]), fast_sigmoid(v0[1])); w.y = cvt_pk_bf16(fast_sigmoid(v0[2]), fast_sigmoid(v0[3]));
                        w.z = cvt_pk_bf16(fast_sigmoid(v1[0]), fast_sigmoid(v1[1])); w.w = cvt_pk_bf16(fast_sigmoid(v1[2]), fast_sigmoid(v1[3]));
                        *(u32x4*)(rowp + bj * HALF) = w; } }
            return;
        }
        const int region = pn >> 2; const bool is64 = region >= 2;
        const float sc = region == 0 ? scA : (region == 2 ? scB : 1.0f);
        const int half = is64 ? 32 : 64;
        const int d0 = is64 ? 4 * (4 * (wc & 1) + fq) : 4 * (4 * wc + fq);
        const int cin = is64 ? (wc >> 1) * 64 + d0 : d0;
        const float* tab = is64 ? T64 : T128;
        bf16_t* base = QK + (size_t)region * ((size_t)8192 * 1024) + (pn & 3) * 256 + cin;
#pragma unroll
        for (int ai = 0; ai < 2; ++ai)
#pragma unroll
            for (int m = 0; m < 4; ++m) { const int row = row0 + ai * HALF + m * 16, pos = row & 4095;
                const f32x4 cv = *(const f32x4*)(tab + (size_t)pos * half + d0), sv = *(const f32x4*)(tab + (size_t)(4096 + pos) * half + d0);
                bf16_t* rowp = base + (size_t)row * 1024;
#pragma unroll
                for (int bj = 0; bj < 2; ++bj) { const f32x4 x1 = acc[ai][bj][m][0], x2 = acc[ai][bj][m][1];
                    const f32x4 o1 = (x1 * cv - x2 * sv) * sc, o2 = (x2 * cv + x1 * sv) * sc;
                    u32x2 w1, w2; w1.x = cvt_pk_bf16(o1[0], o1[1]); w1.y = cvt_pk_bf16(o1[2], o1[3]); w2.x = cvt_pk_bf16(o2[0], o2[1]); w2.y = cvt_pk_bf16(o2[2], o2[3]);
                    *(u32x2*)(rowp + bj * HALF) = w1; *(u32x2*)(rowp + bj * HALF + half) = w2;
                    }
                asm volatile("" ::: "memory"); }
        if (region == 1) {
            f32x4 ks[2][2];
#pragma unroll
            for (int bj = 0; bj < 2; ++bj) { ks[bj][0] = (f32x4){0.f, 0.f, 0.f, 0.f}; ks[bj][1] = (f32x4){0.f, 0.f, 0.f, 0.f}; }
#pragma unroll
            for (int ai = 0; ai < 2; ++ai)
#pragma unroll
                for (int m = 0; m < 4; ++m) { const int row = row0 + ai * HALF + m * 16, pos = row & 4095;
                    const f32x4 cv = *(const f32x4*)(tab + (size_t)pos * half + d0), sv = *(const f32x4*)(tab + (size_t)(4096 + pos) * half + d0);
#pragma unroll
                    for (int bj = 0; bj < 2; ++bj) { const f32x4 x1 = acc[ai][bj][m][0], x2 = acc[ai][bj][m][1];
                        ks[bj][0] += x1 * cv - x2 * sv; ks[bj][1] += x2 * cv + x1 * sv; }
                    asm volatile("" ::: "memory"); }
#pragma unroll
            for (int bj = 0; bj < 2; ++bj)
#pragma unroll
                for (int n = 0; n < 2; ++n)
#pragma unroll
                    for (int j = 0; j < 4; ++j) { float v = ks[bj][n][j]; v += __shfl_xor(v, 1); v += __shfl_xor(v, 2); v += __shfl_xor(v, 4); v += __shfl_xor(v, 8); ks[bj][n][j] = v; }
            if (fr == 0) { const int b = u.pm >> 4, blk = u.pm & 15;
#pragma unroll
                for (int bj = 0; bj < 2; ++bj) { float* kp = kmean + ((size_t)((b * 8 + (pn & 3) * 2 + bj) * 16 + blk)) * 128 + d0;
#pragma unroll
                    for (int n = 0; n < 2; ++n)
#pragma unroll
                        for (int j = 0; j < 4; ++j) atomicAdd(kp + n * 64 + j, ks[bj][n][j] * (1.0f / 256.0f)); } }
        }
    }
};

struct EpiBrA {
    static constexpr bool PERM = true, AFTER_DRAIN = false;
    float* T; const bf16_t* SG;
    __device__ __forceinline__ void operator()(const f32x4 (&acc)[2][2][4][2], const Unit& u, int wr, int wc, int fr, int fq) const {
        const int row0 = u.pm * BM + wr * 64 + fr, col0 = u.pn * BM + wc * 32 + 8 * fq;
#pragma unroll
        for (int ai = 0; ai < 2; ++ai)
#pragma unroll
            for (int m = 0; m < 4; ++m) { const size_t row = (size_t)(row0 + ai * HALF + m * 16);
#pragma unroll
                for (int bj = 0; bj < 2; ++bj) { const u32x4 s = *(const u32x4*)(SG + row * 4096 + col0 + bj * HALF);
                    const f32x4 v0 = acc[ai][bj][m][0], v1 = acc[ai][bj][m][1];
                    f32x4 t0, t1; t0[0] = bf_lo(s.x) * v0[0]; t0[1] = bf_hi(s.x) * v0[1]; t0[2] = bf_lo(s.y) * v0[2]; t0[3] = bf_hi(s.y) * v0[3];
                    t1[0] = bf_lo(s.z) * v1[0]; t1[1] = bf_hi(s.z) * v1[1]; t1[2] = bf_lo(s.w) * v1[2]; t1[3] = bf_hi(s.w) * v1[3];
                    float* tp = T + row * 2048 + col0 + bj * HALF; *(f32x4*)tp = t0; *(f32x4*)(tp + 4) = t1; } }
    }
};
struct EpiBrB {
    static constexpr bool PERM = true, AFTER_DRAIN = false;
    const float* T; const bf16_t* SG; bf16_t* MB;
    __device__ __forceinline__ void operator()(const f32x4 (&acc)[2][2][4][2], const Unit& u, int wr, int wc, int fr, int fq) const {
        const int row0 = u.pm * BM + wr * 64 + fr, col0 = u.pn * BM + wc * 32 + 8 * fq;
#pragma unroll
        for (int ai = 0; ai < 2; ++ai)
#pragma unroll
            for (int m = 0; m < 4; ++m) { const size_t row = (size_t)(row0 + ai * HALF + m * 16);
#pragma unroll
                for (int bj = 0; bj < 2; ++bj) { const u32x4 s = *(const u32x4*)(SG + row * 4096 + 2048 + col0 + bj * HALF);
                    const float* tp = T + row * 2048 + col0 + bj * HALF; const f32x4 a0 = *(const f32x4*)tp, a1 = *(const f32x4*)(tp + 4);
                    const f32x4 v0 = acc[ai][bj][m][0], v1 = acc[ai][bj][m][1];
                    u32x4 w; w.x = cvt_pk_bf16(a0[0] + bf_lo(s.x) * v0[0], a0[1] + bf_hi(s.x) * v0[1]); w.y = cvt_pk_bf16(a0[2] + bf_lo(s.y) * v0[2], a0[3] + bf_hi(s.y) * v0[3]);
                    w.z = cvt_pk_bf16(a1[0] + bf_lo(s.z) * v1[0], a1[1] + bf_hi(s.z) * v1[1]); w.w = cvt_pk_bf16(a1[2] + bf_lo(s.w) * v1[2], a1[3] + bf_hi(s.w) * v1[3]);
                    *(u32x4*)(MB + row * 2048 + col0 + bj * HALF) = w; } }
    }
};
struct EpiRes {
    static constexpr bool PERM = false, AFTER_DRAIN = false;
    const float* base; float* out; float alpha;
    __device__ __forceinline__ void operator()(const f32x4 (&acc)[2][2][4][2], const Unit& u, int wr, int wc, int fr, int fq) const {
        const int row0 = u.pm * BM + wr * 64 + fr, col0 = u.pn * BM + wc * 32 + 4 * fq;
#pragma unroll
        for (int ai = 0; ai < 2; ++ai)
#pragma unroll
            for (int m = 0; m < 4; ++m) { const size_t off = (size_t)(row0 + ai * HALF + m * 16) * 2048 + col0;
#pragma unroll
                for (int bj = 0; bj < 2; ++bj)
#pragma unroll
                    for (int n = 0; n < 2; ++n) { const f32x4 b = *(const f32x4*)(base + off + bj * HALF + n * 16); *(f32x4*)(out + off + bj * HALF + n * 16) = b * alpha + acc[ai][bj][m][n]; } }
    }
};
struct EpiSwiglu {
    static constexpr bool PERM = true, AFTER_DRAIN = false;
    bf16_t* H;
    __device__ __forceinline__ void operator()(const f32x4 (&acc)[2][2][4][2], const Unit& u, int wr, int wc, int fr, int fq) const {
        const int row0 = u.pm * BM + wr * 64 + fr, col0 = u.pn * HALF + wc * 32 + 8 * fq;
#pragma unroll
        for (int ai = 0; ai < 2; ++ai)
#pragma unroll
            for (int m = 0; m < 4; ++m) { const f32x4 g0 = acc[ai][0][m][0], g1 = acc[ai][0][m][1], u0 = acc[ai][1][m][0], u1 = acc[ai][1][m][1];
                f32x4 h0, h1;
#pragma unroll
                for (int j = 0; j < 4; ++j) { h0[j] = g0[j] * fast_sigmoid(g0[j]) * u0[j]; h1[j] = g1[j] * fast_sigmoid(g1[j]) * u1[j]; }
                u32x4 w; w.x = cvt_pk_bf16(h0[0], h0[1]); w.y = cvt_pk_bf16(h0[2], h0[3]); w.z = cvt_pk_bf16(h1[0], h1[1]); w.w = cvt_pk_bf16(h1[2], h1[3]);
                *(u32x4*)(H + (size_t)(row0 + ai * HALF + m * 16) * 5632 + col0) = w; }
    }
};
template <class Epi, class Sched, bool ALIGN_EPI = false, bool SP2 = false>
__device__ __forceinline__ void gemm_phase(PG8_LAS unsigned char* lds, const Gemm g, const Sched& S, const Epi& E) {
    const int tid = threadIdx.x, wid = __builtin_amdgcn_readfirstlane(tid >> 6), lane = tid & 63, wr = wid >> 2, wc = wid & 3, fr = lane & 15, fq = lane >> 4;
    const int K = g.K, nt = K / BK;
    unsigned voffA[2], voffB[2];
#pragma unroll
    for (int i = 0; i < 2; ++i) { int R, C; stage_rc(tid * 16 + i * 8192, R, C); const int Rb = Epi::PERM ? ((R & ~31) + perm32(R & 31)) : R;
        voffA[i] = (unsigned)(R * K + C) * 2u; voffB[i] = (unsigned)(Rb * K + C) * 2u; }
    const size_t kstep = (size_t)(BK * 2);
    const size_t hstep = (size_t)HALF * K * 2;
    const size_t tstep = 2 * hstep;
    const unsigned ldsw = (unsigned)wid * 1024u;
    const int aoff = lds_byte(wr * 64 + fr, fq * 8), boff = lds_byte(wc * 32 + fr, fq * 8);
#define PG8_SA(b, h) (((b) * 2 + (h)) * HTB)
#define PG8_SB(b, h) ((4 + (b) * 2 + (h)) * HTB)
#define PG8_STAGE(bufoff, gbase, voff) do { _Pragma("unroll") for (int _i = 0; _i < 2; ++_i) \
        __builtin_amdgcn_global_load_lds((const unsigned*)((const char*)(gbase) + (voff)[_i]), (PG8_LAS unsigned*)(lds + (bufoff) + ldsw + _i * 8192), 16, 0, 0); } while (0)
#define PG8_LDA(dst, b, h) do { _Pragma("unroll") for (int m = 0; m < 4; ++m) _Pragma("unroll") for (int k = 0; k < 2; ++k) dst[m][k] = *(const PG8_LAS bf16x8*)(lds + PG8_SA(b, h) + aoff + m * 2048 + k * 1024); } while (0)
#define PG8_LDB(dst, b, h) do { _Pragma("unroll") for (int n = 0; n < 2; ++n) _Pragma("unroll") for (int k = 0; k < 2; ++k) dst[n][k] = *(const PG8_LAS bf16x8*)(lds + PG8_SB(b, h) + boff + n * 2048 + k * 1024); } while (0)
#define PG8_MMA(ai, bj, At, Bt) do { __builtin_amdgcn_s_setprio(1); _Pragma("unroll") for (int m = 0; m < 4; ++m) _Pragma("unroll") for (int n = 0; n < 2; ++n) _Pragma("unroll") for (int k = 0; k < 2; ++k) \
        acc[ai][bj][m][n] = __builtin_amdgcn_mfma_f32_16x16x32_bf16(Bt[n][k], At[m][k], acc[ai][bj][m][n], 0, 0, 0); __builtin_amdgcn_s_setprio(0); } while (0)
#define PG8_WAIT_V(n) asm volatile("s_waitcnt vmcnt(" #n ")" ::: "memory")
#define PG8_WAIT_L(n) asm volatile("s_waitcnt lgkmcnt(" #n ")" ::: "memory")
#define PG8_BAR __builtin_amdgcn_s_barrier()
#define PG8_SCHED __builtin_amdgcn_sched_barrier(0)
    Unit cur, nxt; int ui = 0;
    if (!S.next(0, cur)) return;
    f32x4 acc[2][2][4][2];
#pragma unroll
    for (int a = 0; a < 2; ++a)
#pragma unroll
        for (int b = 0; b < 2; ++b)
#pragma unroll
            for (int m = 0; m < 4; ++m)
#pragma unroll
                for (int n = 0; n < 2; ++n) acc[a][b][m][n] = (f32x4){0.f, 0.f, 0.f, 0.f};
    bf16x8 At[4][2], B0[2][2], B1[2][2];
    const char* cA = (const char*)g.A + (size_t)cur.pm * tstep; const char* cB = (const char*)g.Bt + (size_t)cur.pn * tstep;
    S.a_ready(cur);
    if constexpr (SP2) {
        PG8_STAGE(PG8_SB(0, 0), cB, voffB); PG8_STAGE(PG8_SB(0, 1), cB + hstep, voffB); PG8_STAGE(PG8_SA(0, 0), cA, voffA); PG8_STAGE(PG8_SA(0, 1), cA + hstep, voffA);
        if (wr == 1) PG8_BAR;
        PG8_WAIT_V(2); PG8_BAR;
        PG8_STAGE(PG8_SB(1, 0), cB + kstep, voffB); PG8_STAGE(PG8_SA(1, 0), cA + kstep, voffA); PG8_STAGE(PG8_SB(1, 1), cB + hstep + kstep, voffB);
        PG8_WAIT_V(6); PG8_BAR;
    } else {
        PG8_STAGE(PG8_SB(0, 0), cB, voffB); PG8_STAGE(PG8_SA(0, 0), cA, voffA); PG8_STAGE(PG8_SB(0, 1), cB + hstep, voffB); PG8_STAGE(PG8_SA(0, 1), cA + hstep, voffA);
        if (wr == 1) PG8_BAR;
        PG8_WAIT_V(4); PG8_BAR;
        PG8_STAGE(PG8_SB(1, 0), cB + kstep, voffB); PG8_STAGE(PG8_SA(1, 0), cA + kstep, voffA); PG8_STAGE(PG8_SB(1, 1), cB + hstep + kstep, voffB);
        PG8_WAIT_V(6); PG8_BAR;
    }
    for (;;) {
        const bool has_next = S.next(ui + 1, nxt);
        const char* nA = has_next ? (const char*)g.A + (size_t)nxt.pm * tstep : cA; const char* nB = has_next ? (const char*)g.Bt + (size_t)nxt.pn * tstep : cB;
        for (int t = 0; t < nt; t += 2) {
            const bool last = (t == nt - 2);
            const char* a1 = cA + (size_t)(t + 1) * kstep;
            const char* a2 = last ? nA : cA + (size_t)(t + 2) * kstep; const char* b2 = last ? nB : cB + (size_t)(t + 2) * kstep;
            const char* a3 = a2 + kstep; const char* b3 = b2 + kstep;
            if (last && has_next) S.a_ready(nxt);
            if constexpr (SP2) {
            PG8_LDB(B0, 0, 0); PG8_LDB(B1, 0, 1); PG8_SCHED; PG8_LDA(At, 0, 0); PG8_STAGE(PG8_SA(1, 1), a1 + hstep, voffA);
            PG8_WAIT_V(8); PG8_WAIT_L(0); PG8_BAR; PG8_MMA(0, 0, At, B0); PG8_MMA(0, 1, At, B1); PG8_BAR; PG8_SCHED;
            PG8_LDA(At, 0, 1); PG8_STAGE(PG8_SB(0, 0), b2, voffB); PG8_STAGE(PG8_SB(0, 1), b2 + hstep, voffB); PG8_STAGE(PG8_SA(0, 0), a2, voffA);
            PG8_WAIT_V(8); PG8_WAIT_L(0); PG8_BAR; PG8_MMA(1, 0, At, B0); PG8_MMA(1, 1, At, B1); PG8_BAR; PG8_SCHED;
            PG8_LDB(B0, 1, 0); PG8_LDB(B1, 1, 1); PG8_SCHED; PG8_LDA(At, 1, 0); PG8_STAGE(PG8_SA(0, 1), a2 + hstep, voffA);
            PG8_WAIT_V(8); PG8_WAIT_L(0); PG8_BAR; PG8_MMA(0, 0, At, B0); PG8_MMA(0, 1, At, B1); PG8_BAR; PG8_SCHED;
            PG8_LDA(At, 1, 1); PG8_STAGE(PG8_SB(1, 0), b3, voffB); PG8_STAGE(PG8_SB(1, 1), b3 + hstep, voffB); PG8_STAGE(PG8_SA(1, 0), a3, voffA);
            PG8_WAIT_V(8); PG8_WAIT_L(0); PG8_BAR; PG8_MMA(1, 0, At, B0); PG8_MMA(1, 1, At, B1); PG8_BAR; PG8_SCHED;
            } else {
            PG8_LDB(B0, 0, 0); PG8_SCHED; PG8_LDA(At, 0, 0); PG8_STAGE(PG8_SA(1, 1), a1 + hstep, voffA);
            PG8_WAIT_L(8); PG8_BAR; PG8_WAIT_L(0); PG8_MMA(0, 0, At, B0); PG8_BAR; PG8_SCHED;
            PG8_LDB(B1, 0, 1); PG8_STAGE(PG8_SB(0, 0), b2, voffB);
            PG8_BAR; PG8_WAIT_L(0); PG8_MMA(0, 1, At, B1); PG8_BAR;
            PG8_LDA(At, 0, 1); PG8_STAGE(PG8_SA(0, 0), a2, voffA);
            PG8_BAR; PG8_WAIT_L(0); PG8_MMA(1, 0, At, B0); PG8_BAR; PG8_SCHED;
            PG8_STAGE(PG8_SB(0, 1), b2 + hstep, voffB);
            PG8_WAIT_V(6); PG8_BAR; PG8_MMA(1, 1, At, B1); PG8_BAR;
            PG8_LDB(B0, 1, 0); PG8_SCHED; PG8_LDA(At, 1, 0); PG8_STAGE(PG8_SA(0, 1), a2 + hstep, voffA);
            PG8_WAIT_L(8); PG8_BAR; PG8_WAIT_L(0); PG8_MMA(0, 0, At, B0); PG8_BAR; PG8_SCHED;
            PG8_LDB(B1, 1, 1); PG8_STAGE(PG8_SB(1, 0), b3, voffB);
            PG8_BAR; PG8_WAIT_L(0); PG8_MMA(0, 1, At, B1); PG8_BAR;
            PG8_LDA(At, 1, 1); PG8_STAGE(PG8_SA(1, 0), a3, voffA);
            PG8_BAR; PG8_WAIT_L(0); PG8_MMA(1, 0, At, B0); PG8_BAR; PG8_SCHED;
            PG8_STAGE(PG8_SB(1, 1), b3 + hstep, voffB);
            PG8_WAIT_V(6); PG8_BAR; PG8_MMA(1, 1, At, B1); PG8_BAR;
            }
        }
        if constexpr (ALIGN_EPI) { if (wr == 0) PG8_BAR; }
        if constexpr (!Epi::AFTER_DRAIN) { E(acc, cur, wr, wc, fr, fq); S.done(cur); }
        if (!has_next) break;
#pragma unroll
        for (int a = 0; a < 2; ++a)
#pragma unroll
            for (int b = 0; b < 2; ++b)
#pragma unroll
                for (int m = 0; m < 4; ++m)
#pragma unroll
                    for (int n = 0; n < 2; ++n) acc[a][b][m][n] = (f32x4){0.f, 0.f, 0.f, 0.f};
        cur = nxt; cA = nA; cB = nB; ++ui;
        if constexpr (ALIGN_EPI) { if (wr == 1) PG8_BAR; }
    }
    PG8_WAIT_V(0);
    if constexpr (!ALIGN_EPI) { if (wr == 0) PG8_BAR; }
    PG8_BAR;
    if constexpr (Epi::AFTER_DRAIN) { E.fused(acc, cur, wr, wc, fr, fq, lds, wid, lane); S.done(cur); }
#undef PG8_SA
#undef PG8_SB
#undef PG8_STAGE
#undef PG8_LDA
#undef PG8_LDB
#undef PG8_MMA
#undef PG8_WAIT_V
#undef PG8_WAIT_L
#undef PG8_BAR
#undef PG8_SCHED
}
}
namespace att {
#define ATT_LAS __attribute__((address_space(3)))
typedef short bf16x8 __attribute__((ext_vector_type(8)));
typedef float f32x16 __attribute__((ext_vector_type(16)));
typedef float f32x4 __attribute__((ext_vector_type(4)));
typedef unsigned u32x4 __attribute__((ext_vector_type(4)));
typedef unsigned u32x2 __attribute__((ext_vector_type(2)));
typedef unsigned short bf16_t;
constexpr int KROW = 272, VROW = 136, KBYTES = 64 * KROW, VBYTES = 128 * VROW, BUF = KBYTES + VBYTES;
constexpr int KM_OFF = 2 * BUF;
constexpr int ATT_LDS = KM_OFF + 8192;
constexpr float NEG = -1.0e30f;
constexpr int SEQ = 4096, MROWS = 8192;
__device__ __forceinline__ int crow(int r, int hi) { return (r & 3) + 8 * (r >> 2) + 4 * hi; }
typedef float f32x2a_t __attribute__((ext_vector_type(2))); typedef __bf16 bf16x2a_t __attribute__((ext_vector_type(2)));
__device__ __forceinline__ unsigned cvtpk(float lo, float hi) { f32x2a_t v = {lo, hi}; bf16x2a_t b = __builtin_convertvector(v, bf16x2a_t); return __builtin_bit_cast(unsigned, b); }
#define ATT_MFMA(a, b, c) __builtin_amdgcn_mfma_f32_32x32x16_bf16((a), (b), (c), 0, 0, 0)

struct TileRegs { u32x4 k[2]; u32x4 v[2]; };
__device__ __forceinline__ void tile_load(TileRegs& t, const bf16_t* Kh, const bf16_t* Vth, int kv0, int tid) {
    const char* kt = (const char*)(Kh + (size_t)kv0 * 1024); const char* vt = (const char*)(Vth + kv0);
#pragma unroll
    for (int i = 0; i < 2; ++i) { const unsigned c = (unsigned)tid + 512u * i;
        t.k[i] = *(const u32x4*)(kt + (((c >> 4) * 1024u + (c & 15u) * 8u) * 2u));
        t.v[i] = *(const u32x4*)(vt + (((c >> 3) * (unsigned)MROWS + (c & 7u) * 8u) * 2u)); }
}
__device__ __forceinline__ void tile_store(const TileRegs& t, ATT_LAS unsigned char* buf, int tid) {
#pragma unroll
    for (int i = 0; i < 2; ++i) { const int c = tid + 512 * i;
        *(ATT_LAS u32x4*)(buf + (c >> 4) * KROW + (c & 15) * 16) = t.k[i];
        ATT_LAS u32x2* vp = (ATT_LAS u32x2*)(buf + KBYTES + (c >> 3) * VROW + (c & 7) * 16);
        vp[0] = (u32x2){t.v[i].x, t.v[i].y}; vp[1] = (u32x2){t.v[i].z, t.v[i].w}; }
}
__device__ __forceinline__ void softmax_step(f32x16& s, float& m, float& l, f32x16 (&o)[4]) {
    float mx = s[0];
#pragma unroll
    for (int r = 1; r < 16; ++r) mx = fmaxf(mx, s[r]);
    mx = fmaxf(mx, __shfl_xor(mx, 32));
    const float mn = fmaxf(m, mx);
    const float sc = __builtin_amdgcn_exp2f(m - mn);
    m = mn;
    float ps = 0.f;
#pragma unroll
    for (int r = 0; r < 16; ++r) { const float p = __builtin_amdgcn_exp2f(s[r] - mn); s[r] = p; ps += p; }
    l = l * sc + ps;
    if (__builtin_amdgcn_ballot_w64(sc != 1.0f) != 0ull) {
#pragma unroll
        for (int db = 0; db < 4; ++db)
#pragma unroll
            for (int r = 0; r < 16; ++r) o[db][r] *= sc;
    }
}
__device__ __forceinline__ bf16x8 pack8(const f32x16& p, int c) {
    u32x4 w; w.x = cvtpk(p[8 * c], p[8 * c + 1]); w.y = cvtpk(p[8 * c + 2], p[8 * c + 3]); w.z = cvtpk(p[8 * c + 4], p[8 * c + 5]); w.w = cvtpk(p[8 * c + 6], p[8 * c + 7]);
    return __builtin_bit_cast(bf16x8, w);
}
__device__ __forceinline__ bf16x8 vfrag(const ATT_LAS unsigned char* vb, int db, int sub, int c, int r32, int hi) {
    const ATT_LAS unsigned char* p = vb + (32 * db + r32) * VROW + (32 * sub + 16 * c + 4 * hi) * 2;
    const u32x2 lo = *(const ATT_LAS u32x2*)p, h2 = *(const ATT_LAS u32x2*)(p + 16);
    u32x4 w; w.x = lo.x; w.y = lo.y; w.z = h2.x; w.w = h2.y; return __builtin_bit_cast(bf16x8, w);
}

__device__ __forceinline__ void moba_unit(int b, int h, int qb, const bf16_t* QA, const bf16_t* KA, const bf16_t* VT, const float* kmean, bf16_t* YA, ATT_LAS unsigned char* lds) {
    int tid = threadIdx.x; asm volatile("" : "+v"(tid));
    const int lane = tid & 63, r32 = lane & 31, hi = lane >> 5, wid = __builtin_amdgcn_readfirstlane(tid >> 6);
    const bf16_t* Kh = KA + (size_t)b * SEQ * 1024 + h * 128;
    const bf16_t* Vth = VT + (size_t)(h * 128) * MROWS + (size_t)b * SEQ;
    const int qrow = b * SEQ + qb * 256 + wid * 32 + r32;
    __syncthreads();
    { ATT_LAS float* km = (ATT_LAS float*)(lds + KM_OFF); const float* src = kmean + (size_t)((b * 8 + h) * 16) * 128;
      for (int i = tid; i < 2048; i += 512) km[i] = src[i]; }
    bf16x8 qr[8];
#pragma unroll
    for (int st = 0; st < 8; ++st) qr[st] = *(const bf16x8*)(QA + (size_t)qrow * 1024 + h * 128 + st * 16 + hi * 8);
    TileRegs tr; tile_load(tr, Kh, Vth, 0, tid); tile_store(tr, lds, tid);
    __syncthreads();
    unsigned sel = 0u;
    if (qb > 0) {
        float v1 = -INFINITY, v2 = -INFINITY, v3 = -INFINITY; int i1 = 31, i2 = 31, i3 = 31;
        for (int j = 0; j < qb; ++j) {
            const ATT_LAS float* km = (const ATT_LAS float*)(lds + KM_OFF) + j * 128 + hi * 8;
            float dot = 0.f;
#pragma unroll
            for (int st = 0; st < 8; ++st) { const f32x4 k0 = *(const ATT_LAS f32x4*)(km + st * 16), k1 = *(const ATT_LAS f32x4*)(km + st * 16 + 4);
                const u32x4 qw = __builtin_bit_cast(u32x4, qr[st]);
                dot += __uint_as_float(qw.x << 16) * k0[0] + __uint_as_float(qw.x & 0xffff0000u) * k0[1] + __uint_as_float(qw.y << 16) * k0[2] + __uint_as_float(qw.y & 0xffff0000u) * k0[3]
                     + __uint_as_float(qw.z << 16) * k1[0] + __uint_as_float(qw.z & 0xffff0000u) * k1[1] + __uint_as_float(qw.w << 16) * k1[2] + __uint_as_float(qw.w & 0xffff0000u) * k1[3]; }
            dot += __shfl_xor(dot, 32);
            if (dot > v1) { v3 = v2; i3 = i2; v2 = v1; i2 = i1; v1 = dot; i1 = j; }
            else if (dot > v2) { v3 = v2; i3 = i2; v2 = dot; i2 = j; }
            else if (dot > v3) { v3 = dot; i3 = j; }
        }
        sel = (1u << i1) | (1u << i2) | (1u << i3);
    }
    f32x16 o[4];
#pragma unroll
    for (int db = 0; db < 4; ++db)
#pragma unroll
        for (int r = 0; r < 16; ++r) o[db][r] = 0.f;
    float m = NEG, l = 0.f;
    const int NS = 4 * (qb + 1), ql = wid * 32 + r32;
    for (int i = 0; i < NS; ++i) {
        const int j = i >> 2, t = i & 3;
        if (i + 1 < NS) tile_load(tr, Kh, Vth, (i + 1) * 64, tid);
        const ATT_LAS unsigned char* kb = lds + (i & 1) * BUF; const ATT_LAS unsigned char* vb = kb + KBYTES;
        const bool own = (j == qb);
        if (!own || t <= (wid >> 1)) {
            const bool lane_on = own || ((sel >> j) & 1u);
#pragma unroll 1
            for (int sub = 0; sub < 2; ++sub) {
                f32x16 s;
#pragma unroll
                for (int r = 0; r < 16; ++r) s[r] = 0.f;
#pragma unroll
                for (int st = 0; st < 8; ++st) { const bf16x8 a = *(const ATT_LAS bf16x8*)(kb + (32 * sub + r32) * KROW + (16 * st + 8 * hi) * 2); s = ATT_MFMA(a, qr[st], s); }
                if (own) {
#pragma unroll
                    for (int r = 0; r < 16; ++r) { const int kvl = 64 * t + 32 * sub + crow(r, hi); if (kvl > ql) s[r] = NEG; }
                } else {
#pragma unroll
                    for (int r = 0; r < 16; ++r) s[r] = lane_on ? s[r] : NEG;
                }
                softmax_step(s, m, l, o);
#pragma unroll
                for (int c = 0; c < 2; ++c) { const bf16x8 pb = pack8(s, c);
#pragma unroll
                    for (int db = 0; db < 4; ++db) o[db] = ATT_MFMA(vfrag(vb, db, sub, c, r32, hi), pb, o[db]); }
            }
        }
        if (i + 1 < NS) tile_store(tr, lds + ((i + 1) & 1) * BUF, tid);
        __syncthreads();
    }
    l += __shfl_xor(l, 32);
    const float inv = 1.0f / l;
    bf16_t* yp = YA + (size_t)qrow * 1024 + h * 128 + 4 * hi;
#pragma unroll
    for (int db = 0; db < 4; ++db)
#pragma unroll
        for (int g = 0; g < 4; ++g) { u32x2 w; w.x = cvtpk(o[db][4 * g] * inv, o[db][4 * g + 1] * inv); w.y = cvtpk(o[db][4 * g + 2] * inv, o[db][4 * g + 3] * inv);
            *(u32x2*)(yp + 32 * db + 8 * g) = w; }
}

__device__ __forceinline__ void diff_unit(int b, int h, int qi, const bf16_t* QB, const bf16_t* KB, const bf16_t* VT, const float* subln_w, float lam, float out_scale, float* SCR, bf16_t* YB, ATT_LAS unsigned char* lds) {
    const bf16_t* Kh = KB + (size_t)b * SEQ * 1024 + h * 128;
    const bf16_t* Vth = VT + (size_t)(1024 + h * 128) * MROWS + (size_t)b * SEQ;
    const int NS = 4 * (qi + 1);
#pragma unroll 1
    for (int pass = 0; pass < 2; ++pass) {
        int tid = threadIdx.x; asm volatile("" : "+v"(tid));
        const int lane = tid & 63, r32 = lane & 31, hi = lane >> 5, wid = __builtin_amdgcn_readfirstlane(tid >> 6);
        const int qrow = b * SEQ + qi * 256 + wid * 32 + r32, ql = wid * 32 + r32;
        const int koff = pass * 64;
        __syncthreads();
        bf16x8 q[4];
#pragma unroll
        for (int st = 0; st < 4; ++st) q[st] = *(const bf16x8*)(QB + (size_t)qrow * 1024 + h * 128 + koff + st * 16 + hi * 8);
        TileRegs tr; tile_load(tr, Kh, Vth, 0, tid); tile_store(tr, lds, tid);
        __syncthreads();
        f32x16 o[4];
#pragma unroll
        for (int db = 0; db < 4; ++db)
#pragma unroll
            for (int r = 0; r < 16; ++r) o[db][r] = 0.f;
        float m = NEG, l = 0.f;
#pragma unroll 1
        for (int i = 0; i < NS; ++i) {
            if (i + 1 < NS) tile_load(tr, Kh, Vth, (i + 1) * 64, tid);
            const ATT_LAS unsigned char* kb = lds + (i & 1) * BUF; const ATT_LAS unsigned char* vb = kb + KBYTES;
            const int t = i - 4 * qi;
            if (t < 0 || t <= (wid >> 1)) {
#pragma unroll 1
                for (int sub = 0; sub < 2; ++sub) {
                    f32x16 s;
#pragma unroll
                    for (int r = 0; r < 16; ++r) s[r] = 0.f;
#pragma unroll
                    for (int st = 0; st < 4; ++st) s = ATT_MFMA(*(const ATT_LAS bf16x8*)(kb + (32 * sub + r32) * KROW + (koff + 16 * st + 8 * hi) * 2), q[st], s);
                    if (t >= 0) {
#pragma unroll
                        for (int r = 0; r < 16; ++r) { const int kvl = 64 * t + 32 * sub + crow(r, hi); if (kvl > ql) s[r] = NEG; }
                    }
                    softmax_step(s, m, l, o);
#pragma unroll
                    for (int c = 0; c < 2; ++c) { const bf16x8 pb = pack8(s, c);
#pragma unroll
                        for (int db = 0; db < 4; ++db) o[db] = ATT_MFMA(vfrag(vb, db, sub, c, r32, hi), pb, o[db]); }
                }
            }
            if (i + 1 < NS) tile_store(tr, lds + ((i + 1) & 1) * BUF, tid);
            __syncthreads();
        }
        l += __shfl_xor(l, 32);
        float* sp = SCR + (size_t)qrow * 1024 + h * 128 + 4 * hi;
        if (pass == 0) {
            const float inv = 1.0f / l;
#pragma unroll
            for (int db = 0; db < 4; ++db)
#pragma unroll
                for (int g = 0; g < 4; ++g) *(f32x4*)(sp + 32 * db + 8 * g) = (f32x4){o[db][4 * g] * inv, o[db][4 * g + 1] * inv, o[db][4 * g + 2] * inv, o[db][4 * g + 3] * inv};
        } else {
            const float i2 = lam / l;
            float ss = 0.f;
#pragma unroll
            for (int db = 0; db < 4; ++db)
#pragma unroll
                for (int g = 0; g < 4; ++g) { const f32x4 a = *(const f32x4*)(sp + 32 * db + 8 * g);
#pragma unroll
                    for (int k = 0; k < 4; ++k) { const float v = a[k] - o[db][4 * g + k] * i2; o[db][4 * g + k] = v; ss += v * v; }
                    if (g & 1) asm volatile("" ::: "memory"); }
            ss += __shfl_xor(ss, 32);
            const float rs = out_scale / sqrtf(ss * (1.0f / 128.0f) + 1e-5f);
            bf16_t* yp = YB + (size_t)qrow * 1024 + h * 128 + 4 * hi;
#pragma unroll
            for (int db = 0; db < 4; ++db)
#pragma unroll
                for (int g = 0; g < 4; ++g) { const f32x4 w4 = *(const f32x4*)(subln_w + 32 * db + 8 * g + 4 * hi);
                    u32x2 w; w.x = cvtpk(o[db][4 * g] * rs * w4[0], o[db][4 * g + 1] * rs * w4[1]); w.y = cvtpk(o[db][4 * g + 2] * rs * w4[2], o[db][4 * g + 3] * rs * w4[3]);
                    *(u32x2*)(yp + 32 * db + 8 * g) = w;
                    if (g & 1) asm volatile("" ::: "memory"); }
        }
    }
}
}
namespace cg = cooperative_groups;
#ifndef MK_N_LAUNCHES
#define MK_N_LAUNCHES 1
#define MK_DUMP 0
#define MK_DUMP_PH 2
#define MK_DUMP_OFF (WS_R2 + 64 * MiB)
#endif
constexpr int NPHASE = 9;
#ifndef MK_REPS
#define MK_REPS 1
#endif
constexpr int NWAVES = 8;
constexpr int M = 8192, DM = 2048, SEQ = 4096, NIN = 8192  , FFH = 5632;
constexpr float LN_EPS = 1e-5f;
constexpr float ALPHA = 1.189207115002721f;
constexpr float SC_A = 0.08838834764831845f * 1.4426950408889634f, SC_B = 0.125f * 1.4426950408889634f;
constexpr float LAM_INIT = 0.2f;

constexpr size_t MiB = 1u << 20;
constexpr size_t WS_WIN = 1 * MiB, WS_WV = 33 * MiB, WS_WBA = 41 * MiB, WS_WBB = 45 * MiB, WS_WOUT = 49 * MiB, WS_WFI = 57 * MiB, WS_WFO = 101 * MiB;
constexpr size_t WS_T128 = 123 * MiB, WS_T64 = 125 * MiB, WS_KM = 126 * MiB;
constexpr size_t WS_R1 = 128 * MiB;
constexpr size_t WS_R2 = 160 * MiB;
constexpr size_t WS_R3 = 288 * MiB;
constexpr size_t WS_END = 320 * MiB;
constexpr int MISC_OFF = 131072, LDS_BYTES = 131072 + 1024;
constexpr size_t WS_CTL = 0, CTL_ZERO_BYTES = 65536;

#define LAS __attribute__((address_space(3)))
typedef unsigned short bf16;
typedef unsigned v4u __attribute__((ext_vector_type(4)));
typedef unsigned v2u __attribute__((ext_vector_type(2)));
typedef float f32x4 __attribute__((ext_vector_type(4)));
__device__ __forceinline__ unsigned f2bf(float f) { unsigned u = __builtin_bit_cast(unsigned, f); return (u + 0x7fffu + ((u >> 16) & 1u)) >> 16; }
__device__ __forceinline__ unsigned pk2(float lo, float hi) { return f2bf(lo) | (f2bf(hi) << 16); }
__device__ __forceinline__ float wave_sum(float v) {
#pragma unroll
    for (int o = 1; o < 64; o <<= 1) v += __shfl_xor(v, o);
    return v;
}
#define XB_TMO      128
#define XB_XCNT(j)  (256  + 64 * (j))
#define XB_XSUB(j)  (1280 + 64 * (j))
#define XB_XGEN(j)  (2304 + 64 * (j))
#define XB_TOP      3328
#define XB_TOPGEN   3392
#define XCD_BAR_WORDS 3456
#define XB_SPIN_CAP (1u << 18)

__device__ __forceinline__ unsigned xb_ld(unsigned* p)              { return __hip_atomic_load(p, __ATOMIC_RELAXED, __HIP_MEMORY_SCOPE_AGENT); }
__device__ __forceinline__ unsigned xb_add(unsigned* p, unsigned v) { return __hip_atomic_fetch_add(p, v, __ATOMIC_RELAXED, __HIP_MEMORY_SCOPE_AGENT); }
__device__ __forceinline__ unsigned xb_xcc_id() { return (unsigned)__builtin_amdgcn_s_getreg((3 << 11) | 20) & 0xFu; }
#define XB_SPIN(cond, bar) do { unsigned _sp = 0; while (cond) { __builtin_amdgcn_s_sleep(1); \
    if ((++_sp & 255u) == 0u) { if (xb_ld(&(bar)[XB_TMO])) break; if (_sp > XB_SPIN_CAP) { atomicAdd(&(bar)[XB_TMO], 1u); break; } } } } while (0)

struct XcdBarrier {
    unsigned* bar; unsigned x;
    volatile LAS unsigned* st;
};

__device__ __forceinline__ XcdBarrier xcd_barrier_post(unsigned* bar, volatile LAS unsigned* st) {
    XcdBarrier b; b.bar = bar; b.x = xb_xcc_id(); b.st = st;
    if (threadIdx.x == 0) (void)xb_add(&bar[XB_XCNT(b.x)], 1u);
    return b;
}
__device__ __forceinline__ void xcd_barrier_complete(unsigned* bar, unsigned x, unsigned& nloc, unsigned& nx) {
    const unsigned G = gridDim.x * gridDim.y * gridDim.z;
    unsigned sum, cnt, mine, sp = 0u;
    for (;;) {
        sum = 0u; cnt = 0u; mine = 0u;
#pragma unroll
        for (unsigned j = 0; j < 16; ++j) { const unsigned c = xb_ld(&bar[XB_XCNT(j)]); sum += c; cnt += (c > 0u) ? 1u : 0u; mine = (j == x) ? c : mine; }
        if (sum == G) break;
        __builtin_amdgcn_s_sleep(1);
        if ((++sp & 255u) == 0u) { if (xb_ld(&bar[XB_TMO])) break; if (sp > XB_SPIN_CAP) { atomicAdd(&bar[XB_TMO], 1u); break; } }
    }
    nloc = mine > 0u ? mine : 1u; nx = cnt > 0u ? cnt : 1u;
}

__device__ __forceinline__ void xcd_barrier(const XcdBarrier& b) {
    asm volatile("s_waitcnt vmcnt(0)" ::: "memory");
    __syncthreads();
    if (threadIdx.x == 0) {
        unsigned* bar = b.bar;
        __builtin_amdgcn_s_waitcnt(0);
        unsigned nloc = b.st[0], nx = b.st[1];
        if (nloc == 0u) { xcd_barrier_complete(bar, b.x, nloc, nx); b.st[0] = nloc; b.st[1] = nx; }
        const unsigned old = xb_add(&bar[XB_XSUB(b.x)], 1u);
        const unsigned gen = old / nloc;
        if (old + 1u == (gen + 1u) * nloc) {
            __builtin_amdgcn_fence(__ATOMIC_RELEASE, "agent");
            asm volatile("s_waitcnt vmcnt(0)" ::: "memory");
            const unsigned og = xb_add(&bar[XB_TOP], 1u);
            const unsigned tg = og / nx;
            if (og + 1u == (tg + 1u) * nx) xb_add(&bar[XB_TOPGEN], 1u);
            else XB_SPIN(xb_ld(&bar[XB_TOPGEN]) == tg, bar);
            __builtin_amdgcn_fence(__ATOMIC_ACQUIRE, "agent");
            xb_add(&bar[XB_XGEN(b.x)], 1u);
            asm volatile("s_waitcnt vmcnt(0)" ::: "memory");
        } else {
            XB_SPIN(xb_ld(&bar[XB_XGEN(b.x)]) == gen, bar);
            __builtin_amdgcn_fence(__ATOMIC_ACQUIRE, "agent");
            asm volatile("s_waitcnt vmcnt(0)" ::: "memory");
        }
    }
    __syncthreads();
}
__device__ __forceinline__ int src_col_in(int g) {
    if (g >= 4096) return g + 2048;
    const int region = g >> 10, h = (g >> 7) & 7, gl = g & 127, e = gl & 7, blk = gl >> 3;
    const int base = region == 0 ? 0 : region == 1 ? 1024 : region == 2 ? 3072 : 4096;
    const int d = region < 2 ? 4 * blk + (e & 3) + 64 * (e >> 2) : (blk >> 3) * 64 + 4 * (blk & 7) + (e & 3) + 32 * (e >> 2);
    return base + h * 128 + d;
}
__device__ __forceinline__ void p0_item(const float* W, int K, int N, int Ndst, bf16* WT, LAS float* scr, int item, int lane, int mode, int src_off) {
    const int nblk = Ndst / 32, kb = item / nblk, nb = item % nblk, k0 = 64 * kb, g0 = 32 * nb;
    const int g = g0 + (lane & 31);
    const int sc = mode == 0 ? src_off + g : (mode == 1 ? src_col_in(g) : ((g >> 7) & 1) * 5632 + 128 * (g >> 8) + (g & 127));
#pragma unroll 8
    for (int i = 0; i < 32; ++i) { const int kk = 2 * i + (lane >> 5); scr[kk * 33 + (lane & 31)] = W[(size_t)(k0 + kk) * N + sc]; }
    asm volatile("s_waitcnt lgkmcnt(0)" ::: "memory");
    const int c = lane & 7;
#pragma unroll
    for (int j = 0; j < 4; ++j) { const int n = (lane >> 3) + 8 * j; const LAS float* s = scr + (8 * c) * 33 + n;
        v4u o; o.x = pk2(s[0 * 33], s[1 * 33]); o.y = pk2(s[2 * 33], s[3 * 33]); o.z = pk2(s[4 * 33], s[5 * 33]); o.w = pk2(s[6 * 33], s[7 * 33]);
        *(v4u*)(WT + (size_t)(g0 + n) * K + k0 + 8 * c) = o; }
    asm volatile("s_waitcnt lgkmcnt(0)" ::: "memory");
}
__device__ __forceinline__ void ln_row(float* row, const float* gam, const float* bet, bf16* brow, int lane) {
    f32x4* xr = (f32x4*)row + lane; f32x4 v[8]; float s = 0.f;
#pragma unroll
    for (int j = 0; j < 8; ++j) { v[j] = xr[64 * j]; s += (v[j].x + v[j].y) + (v[j].z + v[j].w); }
    const float mean = wave_sum(s) * (1.f / 2048.f); float s2 = 0.f;
#pragma unroll
    for (int j = 0; j < 8; ++j) { v[j] = v[j] - mean; s2 += (v[j].x * v[j].x + v[j].y * v[j].y) + (v[j].z * v[j].z + v[j].w * v[j].w); }
    const float rstd = 1.f / sqrtf(wave_sum(s2) * (1.f / 2048.f) + LN_EPS);
#pragma unroll
    for (int j = 0; j < 8; ++j) { const f32x4 g4 = *((const f32x4*)gam + 64 * j + lane), b4 = *((const f32x4*)bet + 64 * j + lane);
        const f32x4 o = v[j] * rstd * g4 + b4; xr[64 * j] = o;
        if (brow) { v2u w; w.x = pk2(o.x, o.y); w.y = pk2(o.z, o.w); *((v2u*)brow + 64 * j + lane) = w; } }
}

struct Args { const float* in[13]; float* out; unsigned char* ws; int ph_lo, ph_hi, coop, pad; };
__global__ void __launch_bounds__(NWAVES * 64, 2) mk_fwd(Args args) {
    extern __shared__ __attribute__((aligned(16))) unsigned char lds_raw[];
    LAS unsigned char* lds = (LAS unsigned char*)lds_raw;
    const int wave = __builtin_amdgcn_readfirstlane(threadIdx.x >> 6);
    const int G = gridDim.x, bx = blockIdx.x, vcu = (G % 8 == 0) ? (bx % 8) * (G / 8) + bx / 8 : bx;
    unsigned char* ws = args.ws;
    const float* x = args.in[0]; const float* w_in = args.in[1]; const float* lambda_qk = args.in[2]; const float* subln_w = args.in[3];
    const float* w_ba = args.in[4]; const float* w_bb = args.in[5]; const float* w_out = args.in[6]; const float* ln1_g = args.in[7]; const float* ln1_b = args.in[8];
    const float* w_fi = args.in[9]; const float* w_fo = args.in[10]; const float* ln2_g = args.in[11]; const float* ln2_b = args.in[12];
    float* out = args.out;
    bf16* WinT = (bf16*)(ws + WS_WIN); bf16* WvT = (bf16*)(ws + WS_WV); bf16* WbaT = (bf16*)(ws + WS_WBA); bf16* WbbT = (bf16*)(ws + WS_WBB);
    bf16* WoutT = (bf16*)(ws + WS_WOUT); bf16* WfiT = (bf16*)(ws + WS_WFI); bf16* WfoT = (bf16*)(ws + WS_WFO);
    float* T128 = (float*)(ws + WS_T128); float* T64 = (float*)(ws + WS_T64); float* kmean = (float*)(ws + WS_KM);
    bf16* XB = (bf16*)(ws + WS_R1); bf16* YA = (bf16*)(ws + WS_R1); bf16* YB = YA + (size_t)M * 1024; bf16* H1B = (bf16*)(ws + WS_R1);
    bf16* QK = (bf16*)(ws + WS_R2); bf16* SG = QK + (size_t)4 * M * 1024; bf16* HID = (bf16*)(ws + WS_R2);
    bf16* VT = (bf16*)(ws + WS_R3); bf16* MB = (bf16*)(ws + WS_R3);
    const int lo = args.ph_lo, hi = args.ph_hi;
#ifdef ONLY_PHASE
#define IN(k) ((k) == ONLY_PHASE && lo <= (k) && (k) < hi)
#else
#define IN(k) (lo <= (k) && (k) < hi)
#endif
#define SEAM(k) do { if (args.coop && IN(k) && IN((k) + 1)) xcd_barrier(bar); } while (0)
    const int gw = vcu * NWAVES + wave, NGW = G * NWAVES, NGT = G * NWAVES * 64;
    volatile LAS unsigned* MISC = (volatile LAS unsigned*)(lds + MISC_OFF);
    if (threadIdx.x < 32) MISC[threadIdx.x] = 0u;
    __syncthreads();
    XcdBarrier bar; bar.bar = (unsigned*)(ws + WS_CTL); bar.x = 0; bar.st = nullptr;
    if (args.coop) bar = xcd_barrier_post((unsigned*)(ws + WS_CTL), MISC + 8);
    if (args.pad == 0x5a5a) cg::this_grid().sync();

    if (IN(0)) {
        const int tid = threadIdx.x, lane = tid & 63, gt = bx * (NWAVES * 64) + tid;
        LAS float* scr = (LAS float*)(lds + wave * 16384);
        constexpr int I_IN = (DM / 64) * (NIN / 32), I_V = (DM / 64) * (2048 / 32), I_BA = (1024 / 64) * (2048 / 32), I_OUT = (DM / 64) * (2048 / 32), I_FI = (DM / 64) * (2 * FFH / 32), I_FO = (FFH / 64) * (2048 / 32);
        constexpr int NITEMS = I_IN + I_V + 2 * I_BA + I_OUT + I_FI + I_FO;
        for (int it = gw; it < NITEMS; it += NGW) {
            int r = it;
            if (r < I_IN) { p0_item(w_in, DM, 10240, NIN, WinT, scr, r, lane, 1, 0); continue; } r -= I_IN;
            if (r < I_V) { const int nblk = 2048 / 32, nb = r % nblk; p0_item(w_in, DM, 10240, 2048, WvT, scr, r, lane, 0, nb < 32 ? 2048 : 5120 - 1024); continue; } r -= I_V;
            if (r < I_BA) { p0_item(w_ba, 1024, 2048, 2048, WbaT, scr, r, lane, 0, 0); continue; } r -= I_BA;
            if (r < I_BA) { p0_item(w_bb, 1024, 2048, 2048, WbbT, scr, r, lane, 0, 0); continue; } r -= I_BA;
            if (r < I_OUT) { p0_item(w_out, DM, 2048, 2048, WoutT, scr, r, lane, 0, 0); continue; } r -= I_OUT;
            if (r < I_FI) { p0_item(w_fi, DM, 2 * FFH, 2 * FFH, WfiT, scr, r, lane, 2, 0); continue; } r -= I_FI;
            p0_item(w_fo, FFH, 2048, 2048, WfoT, scr, r, lane, 0, 0);
        }
        for (int i = gt; i < M * DM / 8; i += NGT) { const f32x4 a = *((const f32x4*)x + 2 * (size_t)i), b = *((const f32x4*)x + 2 * (size_t)i + 1);
            v4u o; o.x = pk2(a.x, a.y); o.y = pk2(a.z, a.w); o.z = pk2(b.x, b.y); o.w = pk2(b.z, b.w); *((v4u*)XB + i) = o; }
        for (int i = gt; i < SEQ * 96; i += NGT) {
            int pos, f, half; float* tab;
            if (i < SEQ * 64) { pos = i >> 6; f = i & 63; half = 64; tab = T128; } else { const int k = i - SEQ * 64; pos = k >> 5; f = k & 31; half = 32; tab = T64; }
            const float inv_freq = (float)exp2(-(double)f / (double)half * 13.287712379549449);
            const float ang = (float)pos * inv_freq;
            double tt = (double)ang * 0.15915494309189535; tt -= floor(tt);
            tab[(size_t)pos * half + f] = __builtin_amdgcn_cosf((float)tt); tab[(size_t)(SEQ + pos) * half + f] = __builtin_amdgcn_sinf((float)tt);
        }
        for (int i = gt; i < 2 * 8 * 16 * 128; i += NGT) kmean[i] = 0.f;
    }
    SEAM(0);
    if (IN(1)) {
        { pg8::Gemm g{XB, WinT, M, NIN, DM}; pg8::StaticOrder S; S.init(M, NIN, G, bx);
          pg8::EpiIn E{QK, SG, T128, T64, kmean, SC_A, SC_B};
          pg8::gemm_phase<pg8::EpiIn, pg8::StaticOrder, true, true>(lds, g, S, E); }
        { pg8::Gemm g{WvT, XB, 2048, M, DM}; pg8::StaticOrder S; S.init(2048, M, G, bx);
          pg8::EpiStore E{VT, M};
          pg8::gemm_phase<pg8::EpiStore, pg8::StaticOrder, true, true>(lds, g, S, E); }
    }
    SEAM(1);
    if (IN(2)) {
        const int lane = threadIdx.x & 63;
        float sa = 0.f, sb = 0.f;
        { const float a = lambda_qk[lane] * lambda_qk[64 + lane], b = lambda_qk[128 + lane] * lambda_qk[192 + lane]; sa = wave_sum(a); sb = wave_sum(b); }
        const float lam = expf(sa) - expf(sb) + LAM_INIT;
        for (int u = vcu; u < 256; u += G) {
            const int b = u >> 7, h = (u >> 4) & 7, xq = u & 15;
#ifndef NO_MOBA
            att::moba_unit(b, h, xq, QK, QK + (size_t)M * 1024, VT, kmean, YA, lds);
#endif
#ifndef NO_DIFF
            att::diff_unit(b, h, 15 - xq, QK + (size_t)2 * M * 1024, QK + (size_t)3 * M * 1024, VT, subln_w, lam, 1.0f - LAM_INIT, out, YB, lds);
#endif
        }
        __syncthreads();
    }
    SEAM(2);
    if (IN(3)) {
        { pg8::Gemm g{YA, WbaT, M, DM, 1024}; pg8::StaticOrder S; S.init(M, DM, G, bx);
          pg8::EpiBrA E{out, SG};
          pg8::gemm_phase<pg8::EpiBrA, pg8::StaticOrder, true, true>(lds, g, S, E); }
        { pg8::Gemm g{YB, WbbT, M, DM, 1024}; pg8::StaticOrder S; S.init(M, DM, G, bx);
          pg8::EpiBrB E{out, SG, MB};
          pg8::gemm_phase<pg8::EpiBrB, pg8::StaticOrder, true, true>(lds, g, S, E); }
    }
    SEAM(3);
    if (IN(4)) {
        pg8::Gemm g{MB, WoutT, M, DM, DM}; pg8::StaticOrder S; S.init(M, DM, G, bx);
        pg8::EpiRes E{x, out, ALPHA};
        pg8::gemm_phase<pg8::EpiRes, pg8::StaticOrder, true, true>(lds, g, S, E);
    }
    SEAM(4);
    if (IN(5)) { const int lane = threadIdx.x & 63; for (int m = gw; m < M; m += NGW) ln_row(out + (size_t)m * DM, ln1_g, ln1_b, H1B + (size_t)m * DM, lane); }
    SEAM(5);
    if (IN(6)) {
        pg8::Gemm g{H1B, WfiT, M, 2 * FFH, DM}; pg8::StaticOrder S; S.init(M, 2 * FFH, G, bx);
        pg8::EpiSwiglu E{HID};
        pg8::gemm_phase<pg8::EpiSwiglu, pg8::StaticOrder, true, true>(lds, g, S, E);
    }
    SEAM(6);
    if (IN(7)) {
        pg8::Gemm g{HID, WfoT, M, DM, FFH}; pg8::StaticOrder S; S.init(M, DM, G, bx);
        pg8::EpiRes E{out, out, ALPHA};
        pg8::gemm_phase<pg8::EpiRes, pg8::StaticOrder, true, true>(lds, g, S, E);
    }
    SEAM(7);
    if (IN(8)) { const int lane = threadIdx.x & 63; for (int m = gw; m < M; m += NGW) ln_row(out + (size_t)m * DM, ln2_g, ln2_b, nullptr, lane); }
#undef IN
#undef SEAM
}

__global__ void dump_sum4(const unsigned short* a, const unsigned short* b, const unsigned short* c, const unsigned short* d, float* out, int n) {
    for (int i = blockIdx.x * blockDim.x + threadIdx.x; i < n; i += gridDim.x * blockDim.x)
        out[i] = __uint_as_float((unsigned)a[i] << 16) + __uint_as_float((unsigned)b[i] << 16) + __uint_as_float((unsigned)c[i & (2097152 - 1)] << 16) + __uint_as_float((unsigned)d[i & (2097152 - 1)] << 16); }
__global__ void dump_bf16(const unsigned short* src, float* out, int n) { for (int i = blockIdx.x * blockDim.x + threadIdx.x; i < n; i += gridDim.x * blockDim.x) out[i] = __uint_as_float((unsigned)src[i] << 16); }
#ifndef MK_DUMP
#define MK_DUMP 0
#endif
#ifndef MK_DUMP_PH
#define MK_DUMP_PH 3
#define MK_DUMP_OFF WS_R1
#endif
extern "C" void kernel_launch(void* const* d_in, const int* in_sizes, int n_in, void* d_out, int out_size, void* d_ws, size_t ws_size, hipStream_t stream) {
    static int grid = 0;
    if (grid == 0) {
        if (n_in != 13 || in_sizes[0] != M * DM || out_size != M * DM || ws_size < WS_END) { fprintf(stderr, "kernel_launch: unexpected shapes (n_in %d, in0 %d, out %d, ws %zu); nothing launched\n", n_in, n_in > 0 ? in_sizes[0] : -1, out_size, ws_size); grid = -1; return; }
        int dev = 0, cus = 0, per_cu = 0;
        if (hipGetDevice(&dev) != hipSuccess || hipDeviceGetAttribute(&cus, hipDeviceAttributeMultiprocessorCount, dev) != hipSuccess) { grid = -1; return; }
        if (hipFuncSetAttribute((const void*)mk_fwd, hipFuncAttributeMaxDynamicSharedMemorySize, LDS_BYTES) != hipSuccess) { fprintf(stderr, "kernel_launch: hipFuncSetAttribute failed\n"); grid = -1; return; }
        if (hipOccupancyMaxActiveBlocksPerMultiprocessor(&per_cu, (const void*)mk_fwd, NWAVES * 64, LDS_BYTES) != hipSuccess || per_cu < 1) { fprintf(stderr, "kernel_launch: occupancy query gave %d\n", per_cu); per_cu = 1; }
        (void)hipGetLastError();
        grid = cus * per_cu; if (grid > 256) grid = 256;
        grid -= grid % 8; if (grid < 8) grid = 8;
    }
    if (grid < 0) return;
    if (hipMemsetAsync((char*)d_ws + WS_CTL, 0, CTL_ZERO_BYTES, stream) != hipSuccess) { fprintf(stderr, "kernel_launch: hipMemsetAsync failed\n"); return; }
    Args a{};
    for (int i = 0; i < 13; ++i) a.in[i] = (const float*)d_in[i];
    a.out = (float*)d_out; a.ws = (unsigned char*)d_ws;
    if (MK_N_LAUNCHES == 1) {
        a.ph_lo = 0; a.ph_hi = NPHASE; a.coop = 1;
        void* kargs[] = {&a};
        const hipError_t e = hipLaunchCooperativeKernel((const void*)mk_fwd, dim3(grid), dim3(NWAVES * 64), kargs, LDS_BYTES, stream);
        if (e != hipSuccess) fprintf(stderr, "kernel_launch: cooperative launch failed: %s (grid %d)\n", hipGetErrorString(e), grid);
    } else {
        const int lastp = MK_DUMP == 0 ? NPHASE : MK_DUMP_PH;
        for (int rep = 0; rep < MK_REPS; ++rep) for (int p = 0; p < lastp; ++p) { a.ph_lo = p; a.ph_hi = p + 1; a.coop = 0;
            hipLaunchKernelGGL(mk_fwd, dim3(grid), dim3(NWAVES * 64), LDS_BYTES, stream, a); }
        if (MK_DUMP == 2) { hipLaunchKernelGGL(dump_sum4, dim3(2048), dim3(256), 0, stream, (const unsigned short*)((const char*)d_ws + WS_R2 + 64 * MiB), (const unsigned short*)((const char*)d_ws + WS_R2 + 96 * MiB),
            (const unsigned short*)((const char*)d_ws + WS_WBA), (const unsigned short*)((const char*)d_ws + WS_WBB), (float*)d_out, M * DM); }
        else if (MK_DUMP) { hipLaunchKernelGGL(dump_bf16, dim3(2048), dim3(256), 0, stream, (const unsigned short*)((const char*)d_ws + MK_DUMP_OFF), (float*)d_out, M * DM); }
    }
}
```

```cpp
#include <hip/hip_runtime.h>
#include <hip/hip_cooperative_groups.h>
#include <cstdio>
#include <cstdint>
#include <cmath>
namespace pg8 {
#define PG8_LAS __attribute__((address_space(3)))
typedef unsigned short bf16_t;
typedef short bf16x8 __attribute__((ext_vector_type(8)));
typedef float f32x4 __attribute__((ext_vector_type(4)));
typedef unsigned u32x4 __attribute__((ext_vector_type(4)));
constexpr int BM = 256, BK = 64, HALF = 128, HTB = HALF * BK * 2  , STAGE_BYTES = 8 * HTB, NXCD = 8, WGM = 8;

__host__ __device__ __forceinline__ int lds_byte(int r, int c) { const int st = (r >> 4) * 2 + (c >> 5), rr = r & 15, cc = c & 31, ob = rr * 64 + cc * 2; return st * 1024 + (ob ^ (((ob >> 9) & 1) << 5)); }
__host__ __device__ __forceinline__ void stage_rc(int b, int& R, int& C) { const int st = b / 1024, sb = b % 1024, swz = sb ^ (((sb >> 9) & 1) << 5); R = (st >> 1) * 16 + swz / 64; C = (st & 1) * 32 + (swz % 64) / 2; }
__host__ __device__ __forceinline__ int perm32(int rho) { const int n = rho >> 4, i = rho & 15; return 8 * (i >> 2) + 4 * n + (i & 3); }

struct Unit { int pm, pn; };
struct Gemm { const bf16_t* A; const bf16_t* Bt; int M, N, K; };

struct StaticOrder {
    int nM, nN, nwg, G, c;
    __host__ __device__ void init(int M, int N, int G_, int c_) { nM = M / BM; nN = N / BM; nwg = nM * nN; G = G_; c = c_; }
    __host__ __device__ bool next(int i, Unit& u) const {
        const long L = (long)i * G + c; if (L >= nwg) return false;
        int wgid = (int)L; { const int q = nwg / NXCD, r = nwg % NXCD, xcd = wgid % NXCD, off = wgid / NXCD; wgid = (xcd < r ? xcd * (q + 1) : r * (q + 1) + (xcd - r) * q) + off; }
        const int nig = WGM * nN, gid = wgid / nig, fm = gid * WGM, gsz = (nM - fm) < WGM ? (nM - fm) : WGM;
        u.pm = fm + ((wgid % nig) % gsz); u.pn = (wgid % nig) / gsz; return true;
    }
    __device__ __forceinline__ void a_ready(const Unit&) const {}
    __device__ __forceinline__ void done(const Unit&) const {}
};

typedef float f32x2c_t __attribute__((ext_vector_type(2))); typedef __bf16 bf16x2c_t __attribute__((ext_vector_type(2)));
__device__ __forceinline__ unsigned cvt_pk_bf16(float lo, float hi) { f32x2c_t v = {lo, hi}; bf16x2c_t b = __builtin_convertvector(v, bf16x2c_t); return __builtin_bit_cast(unsigned, b); }
typedef float f32x2 __attribute__((ext_vector_type(2)));
typedef unsigned u32x2 __attribute__((ext_vector_type(2)));
__device__ __forceinline__ float fast_sigmoid(float v) { return __builtin_amdgcn_rcpf(1.0f + __builtin_amdgcn_exp2f(-1.4426950408889634f * v)); }
__device__ __forceinline__ float bf_lo(unsigned w) { return __uint_as_float(w << 16); }
__device__ __forceinline__ float bf_hi(unsigned w) { return __uint_as_float(w & 0xffff0000u); }

struct EpiStore {
    static constexpr bool PERM = true, AFTER_DRAIN = false;
    bf16_t* O; int ldc;
    __device__ __forceinline__ void operator()(const f32x4 (&acc)[2][2][4][2], const Unit& u, int wr, int wc, int fr, int fq) const {
        const int row0 = u.pm * BM + wr * 64 + fr, col0 = u.pn * BM + wc * 32 + 8 * fq;
#pragma unroll
        for (int ai = 0; ai < 2; ++ai)
#pragma unroll
            for (int m = 0; m < 4; ++m) { bf16_t* rowp = O + (size_t)(row0 + ai * HALF + m * 16) * ldc + col0;
#pragma unroll
                for (int bj = 0; bj < 2; ++bj) { const f32x4 v0 = acc[ai][bj][m][0], v1 = acc[ai][bj][m][1];
                    u32x4 w; w.x = cvt_pk_bf16(v0[0], v0[1]); w.y = cvt_pk_bf16(v0[2], v0[3]); w.z = cvt_pk_bf16(v1[0], v1[1]); w.w = cvt_pk_bf16(v1[2], v1[3]);
                    *(u32x4*)(rowp + bj * HALF) = w; } }
    }
};

struct EpiIn {
    static constexpr bool PERM = true, AFTER_DRAIN = false;
    bf16_t* QK;
    bf16_t* SG;
    const float* T128;
    const float* T64;
    float* kmean;
    float scA, scB;
    __device__ __forceinline__ void operator()(const f32x4 (&acc)[2][2][4][2], const Unit& u, int wr, int wc, int fr, int fq) const {
        const int pn = u.pn, row0 = u.pm * BM + wr * 64 + fr;
        if (pn >= 16) {
            const int col0 = (pn - 16) * BM + wc * 32 + 8 * fq;
#pragma unroll
            for (int ai = 0; ai < 2; ++ai)
#pragma unroll
                for (int m = 0; m < 4; ++m) { bf16_t* rowp = SG + (size_t)(row0 + ai * HALF + m * 16) * 4096 + col0;
#pragma unroll
                    for (int bj = 0; bj < 2; ++bj) { const f32x4 v0 = acc[ai][bj][m][0], v1 = acc[ai][bj][m][1];
                        u32x4 w; w.x = cvt_pk_bf16(fast_sigmoid(v0[0]), fast_sigmoid(v0[1])); w.y = cvt_pk_bf16(fast_sigmoid(v0[2]), fast_sigmoid(v0[3]));
                        w.z = cvt_pk_bf16(fast_sigmoid(v1[0]), fast_sigmoid(v1[1])); w.w = cvt_pk_bf16(fast_sigmoid(v1[2]), fast_sigmoid(v1[3]));
                        *(u32x4*)(rowp + bj * HALF) = w; } }
            return;
        }
        const int region = pn >> 2; const bool is64 = region >= 2;
        const float sc = region == 0 ? scA : (region == 2 ? scB : 1.0f);
        const int half = is64 ? 32 : 64;
        const int d0 = is64 ? 4 * (4 * (wc & 1) + fq) : 4 * (4 * wc + fq);
        const int cin = is64 ? (wc >> 1) * 64 + d0 : d0;
        const float* tab = is64 ? T64 : T128;
        bf16_t* base = QK + (size_t)region * ((size_t)8192 * 1024) + (pn & 3) * 256 + cin;
#pragma unroll
        for (int ai = 0; ai < 2; ++ai)
#pragma unroll
            for (int m = 0; m < 4; ++m) { const int row = row0 + ai * HALF + m * 16, pos = row & 4095;
                const f32x4 cv = *(const f32x4*)(tab + (size_t)pos * half + d0), sv = *(const f32x4*)(tab + (size_t)(4096 + pos) * half + d0);
                bf16_t* rowp = base + (size_t)row * 1024;
#pragma unroll
                for (int bj = 0; bj < 2; ++bj) { const f32x4 x1 = acc[ai][bj][m][0], x2 = acc[ai][bj][m][1];
                    const f32x4 o1 = (x1 * cv - x2 * sv) * sc, o2 = (x2 * cv + x1 * sv) * sc;
                    u32x2 w1, w2; w1.x = cvt_pk_bf16(o1[0], o1[1]); w1.y = cvt_pk_bf16(o1[2], o1[3]); w2.x = cvt_pk_bf16(o2[0], o2[1]); w2.y = cvt_pk_bf16(o2[2], o2[3]);
                    *(u32x2*)(rowp + bj * HALF) = w1; *(u32x2*)(rowp + bj * HALF + half) = w2;
                    }
                asm volatile("" ::: "memory"); }
        if (region == 1) {
            f32x4 ks[2][2];
#pragma unroll
            for (int bj = 0; bj < 2; ++bj) { ks[bj][0] = (f32x4){0.f, 0.f, 0.f, 0.f}; ks[bj][1] = (f32x4){0.f, 0.f, 0.f, 0.f}; }
#pragma unroll
            for (int ai = 0; ai < 2; ++ai)
#pragma unroll
                for (int m = 0; m < 4; ++m) { const int row = row0 + ai * HALF + m * 16, pos = row & 4095;
                    const f32x4 cv = *(const f32x4*)(tab + (size_t)pos * half + d0), sv = *(const f32x4*)(tab + (size_t)(4096 + pos) * half + d0);
#pragma unroll
                    for (int bj = 0; bj < 2; ++bj) { const f32x4 x1 = acc[ai][bj][m][0], x2 = acc[ai][bj][m][1];
                        ks[bj][0] += x1 * cv - x2 * sv; ks[bj][1] += x2 * cv + x1 * sv; }
                    asm volatile("" ::: "memory"); }
#pragma unroll
            for (int bj = 0; bj < 2; ++bj)
#pragma unroll
                for (int n = 0; n < 2; ++n)
#pragma unroll
                    for (int j = 0; j < 4; ++j) { float v = ks[bj][n][j]; v += __shfl_xor(v, 1); v += __shfl_xor(v, 2); v += __shfl_xor(v, 4); v += __shfl_xor(v, 8); ks[bj][n][j] = v; }
            if (fr == 0) { const int b = u.pm >> 4, blk = u.pm & 15;
#pragma unroll
                for (int bj = 0; bj < 2; ++bj) { float* kp = kmean + ((size_t)((b * 8 + (pn & 3) * 2 + bj) * 16 + blk)) * 128 + d0;
#pragma unroll
                    for (int n = 0; n < 2; ++n)
#pragma unroll
                        for (int j = 0; j < 4; ++j) atomicAdd(kp + n * 64 + j, ks[bj][n][j] * (1.0f / 256.0f)); } }
        }
    }
};

struct EpiBrA {
    static constexpr bool PERM = true, AFTER_DRAIN = false;
    float* T; const bf16_t* SG;
    __device__ __forceinline__ void operator()(const f32x4 (&acc)[2][2][4][2], const Unit& u, int wr, int wc, int fr, int fq) const {
        const int row0 = u.pm * BM + wr * 64 + fr, col0 = u.pn * BM + wc * 32 + 8 * fq;
#pragma unroll
        for (int ai = 0; ai < 2; ++ai)
#pragma unroll
            for (int m = 0; m < 4; ++m) { const size_t row = (size_t)(row0 + ai * HALF + m * 16);
#pragma unroll
                for (int bj = 0; bj < 2; ++bj) { const u32x4 s = *(const u32x4*)(SG + row * 4096 + col0 + bj * HALF);
                    const f32x4 v0 = acc[ai][bj][m][0], v1 = acc[ai][bj][m][1];
                    f32x4 t0, t1; t0[0] = bf_lo(s.x) * v0[0]; t0[1] = bf_hi(s.x) * v0[1]; t0[2] = bf_lo(s.y) * v0[2]; t0[3] = bf_hi(s.y) * v0[3];
                    t1[0] = bf_lo(s.z) * v1[0]; t1[1] = bf_hi(s.z) * v1[1]; t1[2] = bf_lo(s.w) * v1[2]; t1[3] = bf_hi(s.w) * v1[3];
                    float* tp = T + row * 2048 + col0 + bj * HALF; *(f32x4*)tp = t0; *(f32x4*)(tp + 4) = t1; } }
    }
};
struct EpiBrB {
    static constexpr bool PERM = true, AFTER_DRAIN = false;
    const float* T; const bf16_t* SG; bf16_t* MB;
    __device__ __forceinline__ void operator()(const f32x4 (&acc)[2][2][4][2], const Unit& u, int wr, int wc, int fr, int fq) const {
        const int row0 = u.pm * BM + wr * 64 + fr, col0 = u.pn * BM + wc * 32 + 8 * fq;
#pragma unroll
        for (int ai = 0; ai < 2; ++ai)
#pragma unroll
            for (int m = 0; m < 4; ++m) { const size_t row = (size_t)(row0 + ai * HALF + m * 16);
#pragma unroll
                for (int bj = 0; bj < 2; ++bj) { const u32x4 s = *(const u32x4*)(SG + row * 4096 + 2048 + col0 + bj * HALF);
                    const float* tp = T + row * 2048 + col0 + bj * HALF; const f32x4 a0 = *(const f32x4*)tp, a1 = *(const f32x4*)(tp + 4);
                    const f32x4 v0 = acc[ai][bj][m][0], v1 = acc[ai][bj][m][1];
                    u32x4 w; w.x = cvt_pk_bf16(a0[0] + bf_lo(s.x) * v0[0], a0[1] + bf_hi(s.x) * v0[1]); w.y = cvt_pk_bf16(a0[2] + bf_lo(s.y) * v0[2], a0[3] + bf_hi(s.y) * v0[3]);
                    w.z = cvt_pk_bf16(a1[0] + bf_lo(s.z) * v1[0], a1[1] + bf_hi(s.z) * v1[1]); w.w = cvt_pk_bf16(a1[2] + bf_lo(s.w) * v1[2], a1[3] + bf_hi(s.w) * v1[3]);
                    *(u32x4*)(MB + row * 2048 + col0 + bj * HALF) = w; } }
    }
};
struct EpiRes {
    static constexpr bool PERM = false, AFTER_DRAIN = false;
    const float* base; float* out; float alpha;
    __device__ __forceinline__ void operator()(const f32x4 (&acc)[2][2][4][2], const Unit& u, int wr, int wc, int fr, int fq) const {
        const int row0 = u.pm * BM + wr * 64 + fr, col0 = u.pn * BM + wc * 32 + 4 * fq;
#pragma unroll
        for (int ai = 0; ai < 2; ++ai)
#pragma unroll
            for (int m = 0; m < 4; ++m) { const size_t off = (size_t)(row0 + ai * HALF + m * 16) * 2048 + col0;
#pragma unroll
                for (int bj = 0; bj < 2; ++bj)
#pragma unroll
                    for (int n = 0; n < 2; ++n) { const f32x4 b = *(const f32x4*)(base + off + bj * HALF + n * 16); *(f32x4*)(out + off + bj * HALF + n * 16) = b * alpha + acc[ai][bj][m][n]; } }
    }
};
struct EpiSwiglu {
    static constexpr bool PERM = true, AFTER_DRAIN = false;
    bf16_t* H;
    __device__ __forceinline__ void operator()(const f32x4 (&acc)[2][2][4][2], const Unit& u, int wr, int wc, int fr, int fq) const {
        const int row0 = u.pm * BM + wr * 64 + fr, col0 = u.pn * HALF + wc * 32 + 8 * fq;
#pragma unroll
        for (int ai = 0; ai < 2; ++ai)
#pragma unroll
            for (int m = 0; m < 4; ++m) { const f32x4 g0 = acc[ai][0][m][0], g1 = acc[ai][0][m][1], u0 = acc[ai][1][m][0], u1 = acc[ai][1][m][1];
                f32x4 h0, h1;
#pragma unroll
                for (int j = 0; j < 4; ++j) { h0[j] = g0[j] * fast_sigmoid(g0[j]) * u0[j]; h1[j] = g1[j] * fast_sigmoid(g1[j]) * u1[j]; }
                u32x4 w; w.x = cvt_pk_bf16(h0[0], h0[1]); w.y = cvt_pk_bf16(h0[2], h0[3]); w.z = cvt_pk_bf16(h1[0], h1[1]); w.w = cvt_pk_bf16(h1[2], h1[3]);
                *(u32x4*)(H + (size_t)(row0 + ai * HALF + m * 16) * 5632 + col0) = w; }
    }
};
template <class Epi, class Sched, bool ALIGN_EPI = false, bool SP2 = false>
__device__ __forceinline__ void gemm_phase(PG8_LAS unsigned char* lds, const Gemm g, const Sched& S, const Epi& E) {
    const int tid = threadIdx.x, wid = __builtin_amdgcn_readfirstlane(tid >> 6), lane = tid & 63, wr = wid >> 2, wc = wid & 3, fr = lane & 15, fq = lane >> 4;
    const int K = g.K, nt = K / BK;
    unsigned voffA[2], voffB[2];
#pragma unroll
    for (int i = 0; i < 2; ++i) { int R, C; stage_rc(tid * 16 + i * 8192, R, C); const int Rb = Epi::PERM ? ((R & ~31) + perm32(R & 31)) : R;
        voffA[i] = (unsigned)(R * K + C) * 2u; voffB[i] = (unsigned)(Rb * K + C) * 2u; }
    const size_t kstep = (size_t)(BK * 2);
    const size_t hstep = (size_t)HALF * K * 2;
    const size_t tstep = 2 * hstep;
    const unsigned ldsw = (unsigned)wid * 1024u;
    const int aoff = lds_byte(wr * 64 + fr, fq * 8), boff = lds_byte(wc * 32 + fr, fq * 8);
#define PG8_SA(b, h) (((b) * 2 + (h)) * HTB)
#define PG8_SB(b, h) ((4 + (b) * 2 + (h)) * HTB)
#define PG8_STAGE(bufoff, gbase, voff) do { _Pragma("unroll") for (int _i = 0; _i < 2; ++_i) \
        __builtin_amdgcn_global_load_lds((const unsigned*)((const char*)(gbase) + (voff)[_i]), (PG8_LAS unsigned*)(lds + (bufoff) + ldsw + _i * 8192), 16, 0, 0); } while (0)
#define PG8_LDA(dst, b, h) do { _Pragma("unroll") for (int m = 0; m < 4; ++m) _Pragma("unroll") for (int k = 0; k < 2; ++k) dst[m][k] = *(const PG8_LAS bf16x8*)(lds + PG8_SA(b, h) + aoff + m * 2048 + k * 1024); } while (0)
#define PG8_LDB(dst, b, h) do { _Pragma("unroll") for (int n = 0; n < 2; ++n) _Pragma("unroll") for (int k = 0; k < 2; ++k) dst[n][k] = *(const PG8_LAS bf16x8*)(lds + PG8_SB(b, h) + boff + n * 2048 + k * 1024); } while (0)
#define PG8_MMA(ai, bj, At, Bt) do { __builtin_amdgcn_s_setprio(1); _Pragma("unroll") for (int m = 0; m < 4; ++m) _Pragma("unroll") for (int n = 0; n < 2; ++n) _Pragma("unroll") for (int k = 0; k < 2; ++k) \
        acc[ai][bj][m][n] = __builtin_amdgcn_mfma_f32_16x16x32_bf16(Bt[n][k], At[m][k], acc[ai][bj][m][n], 0, 0, 0); __builtin_amdgcn_s_setprio(0); } while (0)
#define PG8_WAIT_V(n) asm volatile("s_waitcnt vmcnt(" #n ")" ::: "memory")
#define PG8_WAIT_L(n) asm volatile("s_waitcnt lgkmcnt(" #n ")" ::: "memory")
#define PG8_BAR __builtin_amdgcn_s_barrier()
#define PG8_SCHED __builtin_amdgcn_sched_barrier(0)
    Unit cur, nxt; int ui = 0;
    if (!S.next(0, cur)) return;
    f32x4 acc[2][2][4][2];
#pragma unroll
    for (int a = 0; a < 2; ++a)
#pragma unroll
        for (int b = 0; b < 2; ++b)
#pragma unroll
            for (int m = 0; m < 4; ++m)
#pragma unroll
                for (int n = 0; n < 2; ++n) acc[a][b][m][n] = (f32x4){0.f, 0.f, 0.f, 0.f};
    bf16x8 At[4][2], B0[2][2], B1[2][2];
    const char* cA = (const char*)g.A + (size_t)cur.pm * tstep; const char* cB = (const char*)g.Bt + (size_t)cur.pn * tstep;
    S.a_ready(cur);
    if constexpr (SP2) {
        PG8_STAGE(PG8_SB(0, 0), cB, voffB); PG8_STAGE(PG8_SB(0, 1), cB + hstep, voffB); PG8_STAGE(PG8_SA(0, 0), cA, voffA); PG8_STAGE(PG8_SA(0, 1), cA + hstep, voffA);
        if (wr == 1) PG8_BAR;
        PG8_WAIT_V(2); PG8_BAR;
        PG8_STAGE(PG8_SB(1, 0), cB + kstep, voffB); PG8_STAGE(PG8_SA(1, 0), cA + kstep, voffA); PG8_STAGE(PG8_SB(1, 1), cB + hstep + kstep, voffB);
        PG8_WAIT_V(6); PG8_BAR;
    } else {
        PG8_STAGE(PG8_SB(0, 0), cB, voffB); PG8_STAGE(PG8_SA(0, 0), cA, voffA); PG8_STAGE(PG8_SB(0, 1), cB + hstep, voffB); PG8_STAGE(PG8_SA(0, 1), cA + hstep, voffA);
        if (wr == 1) PG8_BAR;
        PG8_WAIT_V(4); PG8_BAR;
        PG8_STAGE(PG8_SB(1, 0), cB + kstep, voffB); PG8_STAGE(PG8_SA(1, 0), cA + kstep, voffA); PG8_STAGE(PG8_SB(1, 1), cB + hstep + kstep, voffB);
        PG8_WAIT_V(6); PG8_BAR;
    }
    for (;;) {
        const bool has_next = S.next(ui + 1, nxt);
        const char* nA = has_next ? (const char*)g.A + (size_t)nxt.pm * tstep : cA; const char* nB = has_next ? (const char*)g.Bt + (size_t)nxt.pn * tstep : cB;
        for (int t = 0; t < nt; t += 2) {
            const bool last = (t == nt - 2);
            const char* a1 = cA + (size_t)(t + 1) * kstep;
            const char* a2 = last ? nA : cA + (size_t)(t + 2) * kstep; const char* b2 = last ? nB : cB + (size_t)(t + 2) * kstep;
            const char* a3 = a2 + kstep; const char* b3 = b2 + kstep;
            if (last && has_next) S.a_ready(nxt);
            if constexpr (SP2) {
            PG8_LDB(B0, 0, 0); PG8_LDB(B1, 0, 1); PG8_SCHED; PG8_LDA(At, 0, 0); PG8_STAGE(PG8_SA(1, 1), a1 + hstep, voffA);
            PG8_WAIT_V(8); PG8_WAIT_L(0); PG8_BAR; PG8_MMA(0, 0, At, B0); PG8_MMA(0, 1, At, B1); PG8_BAR; PG8_SCHED;
            PG8_LDA(At, 0, 1); PG8_STAGE(PG8_SB(0, 0), b2, voffB); PG8_STAGE(PG8_SB(0, 1), b2 + hstep, voffB); PG8_STAGE(PG8_SA(0, 0), a2, voffA);
            PG8_WAIT_V(8); PG8_WAIT_L(0); PG8_BAR; PG8_MMA(1, 0, At, B0); PG8_MMA(1, 1, At, B1); PG8_BAR; PG8_SCHED;
            PG8_LDB(B0, 1, 0); PG8_LDB(B1, 1, 1); PG8_SCHED; PG8_LDA(At, 1, 0); PG8_STAGE(PG8_SA(0, 1), a2 + hstep, voffA);
            PG8_WAIT_V(8); PG8_WAIT_L(0); PG8_BAR; PG8_MMA(0, 0, At, B0); PG8_MMA(0, 1, At, B1); PG8_BAR; PG8_SCHED;
            PG8_LDA(At, 1, 1); PG8_STAGE(PG8_SB(1, 0), b3, voffB); PG8_STAGE(PG8_SB(1, 1), b3 + hstep, voffB); PG8_STAGE(PG8_SA(1, 0), a3, voffA);
            PG8_WAIT_V(8); PG8_WAIT_L(0); PG8_BAR; PG8_MMA(1, 0, At, B0); PG8_MMA(1, 1, At, B1); PG8_BAR; PG8_SCHED;
            } else {
            PG8_LDB(B0, 0, 0); PG8_SCHED; PG8_LDA(At, 0, 0); PG8_STAGE(PG8_SA(1, 1), a1 + hstep, voffA);
            PG8_WAIT_L(8); PG8_BAR; PG8_WAIT_L(0); PG8_MMA(0, 0, At, B0); PG8_BAR; PG8_SCHED;
            PG8_LDB(B1, 0, 1); PG8_STAGE(PG8_SB(0, 0), b2, voffB);
            PG8_BAR; PG8_WAIT_L(0); PG8_MMA(0, 1, At, B1); PG8_BAR;
            PG8_LDA(At, 0, 1); PG8_STAGE(PG8_SA(0, 0), a2, voffA);
            PG8_BAR; PG8_WAIT_L(0); PG8_MMA(1, 0, At, B0); PG8_BAR; PG8_SCHED;
            PG8_STAGE(PG8_SB(0, 1), b2 + hstep, voffB);
            PG8_WAIT_V(6); PG8_BAR; PG8_MMA(1, 1, At, B1); PG8_BAR;
            PG8_LDB(B0, 1, 0); PG8_SCHED; PG8_LDA(At, 1, 0); PG8_STAGE(PG8_SA(0, 1), a2 + hstep, voffA);
            PG8_WAIT_L(8); PG8_BAR; PG8_WAIT_L(0); PG8_MMA(0, 0, At, B0); PG8_BAR; PG8_SCHED;
            PG8_LDB(B1, 1, 1); PG8_STAGE(PG8_SB(1, 0), b3, voffB);
            PG8_BAR; PG8_WAIT_L(0); PG8_MMA(0, 1, At, B1); PG8_BAR;
            PG8_LDA(At, 1, 1); PG8_STAGE(PG8_SA(1, 0), a3, voffA);
            PG8_BAR; PG8_WAIT_L(0); PG8_MMA(1, 0, At, B0); PG8_BAR; PG8_SCHED;
            PG8_STAGE(PG8_SB(1, 1), b3 + hstep, voffB);
            PG8_WAIT_V(6); PG8_BAR; PG8_MMA(1, 1, At, B1); PG8_BAR;
            }
        }
        if constexpr (ALIGN_EPI) { if (wr == 0) PG8_BAR; }
        if constexpr (!Epi::AFTER_DRAIN) { E(acc, cur, wr, wc, fr, fq); S.done(cur); }
        if (!has_next) break;
#pragma unroll
        for (int a = 0; a < 2; ++a)
#pragma unroll
            for (int b = 0; b < 2; ++b)
#pragma unroll
                for (int m = 0; m < 4; ++m)
#pragma unroll
                    for (int n = 0; n < 2; ++n) acc[a][b][m][n] = (f32x4){0.f, 0.f, 0.f, 0.f};
        cur = nxt; cA = nA; cB = nB; ++ui;
        if constexpr (ALIGN_EPI) { if (wr == 1) PG8_BAR; }
    }
    PG8_WAIT_V(0);
    if constexpr (!ALIGN_EPI) { if (wr == 0) PG8_BAR; }
    PG8_BAR;
    if constexpr (Epi::AFTER_DRAIN) { E.fused(acc, cur, wr, wc, fr, fq, lds, wid, lane); S.done(cur); }
#undef PG8_SA
#undef PG8_SB
#undef PG8_STAGE
#undef PG8_LDA
#undef PG8_LDB
#undef PG8_MMA
#undef PG8_WAIT_V
#undef PG8_WAIT_L
#undef PG8_BAR
#undef PG8_SCHED
}
}
namespace att {
#define ATT_LAS __attribute__((address_space(3)))
typedef short bf16x8 __attribute__((ext_vector_type(8)));
typedef float f32x16 __attribute__((ext_vector_type(16)));
typedef float f32x4 __attribute__((ext_vector_type(4)));
typedef unsigned u32x4 __attribute__((ext_vector_type(4)));
typedef unsigned u32x2 __attribute__((ext_vector_type(2)));
typedef unsigned short bf16_t;
constexpr int KROW = 272, VROW = 136, KBYTES = 64 * KROW, VBYTES = 128 * VROW, BUF = KBYTES + VBYTES;
constexpr int KM_OFF = 2 * BUF;
constexpr int ATT_LDS = KM_OFF + 8192;
constexpr float NEG = -1.0e30f;
constexpr int SEQ = 4096, MROWS = 8192;
__device__ __forceinline__ int crow(int r, int hi) { return (r & 3) + 8 * (r >> 2) + 4 * hi; }
typedef float f32x2a_t __attribute__((ext_vector_type(2))); typedef __bf16 bf16x2a_t __attribute__((ext_vector_type(2)));
__device__ __forceinline__ unsigned cvtpk(float lo, float hi) { f32x2a_t v = {lo, hi}; bf16x2a_t b = __builtin_convertvector(v, bf16x2a_t); return __builtin_bit_cast(unsigned, b); }
#define ATT_MFMA(a, b, c) __builtin_amdgcn_mfma_f32_32x32x16_bf16((a), (b), (c), 0, 0, 0)

struct TileRegs { u32x4 k[2]; u32x4 v[2]; };
__device__ __forceinline__ void tile_load(TileRegs& t, const bf16_t* Kh, const bf16_t* Vth, int kv0, int tid) {
    const char* kt = (const char*)(Kh + (size_t)kv0 * 1024); const char* vt = (const char*)(Vth + kv0);
#pragma unroll
    for (int i = 0; i < 2; ++i) { const unsigned c = (unsigned)tid + 512u * i;
        t.k[i] = *(const u32x4*)(kt + (((c >> 4) * 1024u + (c & 15u) * 8u) * 2u));
        t.v[i] = *(const u32x4*)(vt + (((c >> 3) * (unsigned)MROWS + (c & 7u) * 8u) * 2u)); }
}
__device__ __forceinline__ void tile_store(const TileRegs& t, ATT_LAS unsigned char* buf, int tid) {
#pragma unroll
    for (int i = 0; i < 2; ++i) { const int c = tid + 512 * i;
        *(ATT_LAS u32x4*)(buf + (c >> 4) * KROW + (c & 15) * 16) = t.k[i];
        ATT_LAS u32x2* vp = (ATT_LAS u32x2*)(buf + KBYTES + (c >> 3) * VROW + (c & 7) * 16);
        vp[0] = (u32x2){t.v[i].x, t.v[i].y}; vp[1] = (u32x2){t.v[i].z, t.v[i].w}; }
}
__device__ __forceinline__ void softmax_step(f32x16& s, float& m, float& l, f32x16 (&o)[4]) {
    float mx = s[0];
#pragma unroll
    for (int r = 1; r < 16; ++r) mx = fmaxf(mx, s[r]);
    mx = fmaxf(mx, __shfl_xor(mx, 32));
    const float mn = fmaxf(m, mx);
    const float sc = __builtin_amdgcn_exp2f(m - mn);
    m = mn;
    float ps = 0.f;
#pragma unroll
    for (int r = 0; r < 16; ++r) { const float p = __builtin_amdgcn_exp2f(s[r] - mn); s[r] = p; ps += p; }
    l = l * sc + ps;
    if (__builtin_amdgcn_ballot_w64(sc != 1.0f) != 0ull) {
#pragma unroll
        for (int db = 0; db < 4; ++db)
#pragma unroll
            for (int r = 0; r < 16; ++r) o[db][r] *= sc;
    }
}
__device__ __forceinline__ bf16x8 pack8(const f32x16& p, int c) {
    u32x4 w; w.x = cvtpk(p[8 * c], p[8 * c + 1]); w.y = cvtpk(p[8 * c + 2], p[8 * c + 3]); w.z = cvtpk(p[8 * c + 4], p[8 * c + 5]); w.w = cvtpk(p[8 * c + 6], p[8 * c + 7]);
    return __builtin_bit_cast(bf16x8, w);
}
__device__ __forceinline__ bf16x8 vfrag(const ATT_LAS unsigned char* vb, int db, int sub, int c, int r32, int hi) {
    const ATT_LAS unsigned char* p = vb + (32 * db + r32) * VROW + (32 * sub + 16 * c + 4 * hi) * 2;
    const u32x2 lo = *(const ATT_LAS u32x2*)p, h2 = *(const ATT_LAS u32x2*)(p + 16);
    u32x4 w; w.x = lo.x; w.y = lo.y; w.z = h2.x; w.w = h2.y; return __builtin_bit_cast(bf16x8, w);
}

__device__ __forceinline__ void moba_unit(int b, int h, int qb, const bf16_t* QA, const bf16_t* KA, const bf16_t* VT, const float* kmean, bf16_t* YA, ATT_LAS unsigned char* lds) {
    int tid = threadIdx.x; asm volatile("" : "+v"(tid));
    const int lane = tid & 63, r32 = lane & 31, hi = lane >> 5, wid = __builtin_amdgcn_readfirstlane(tid >> 6);
    const bf16_t* Kh = KA + (size_t)b * SEQ * 1024 + h * 128;
    const bf16_t* Vth = VT + (size_t)(h * 128) * MROWS + (size_t)b * SEQ;
    const int qrow = b * SEQ + qb * 256 + wid * 32 + r32;
    __syncthreads();
    { ATT_LAS float* km = (ATT_LAS float*)(lds + KM_OFF); const float* src = kmean + (size_t)((b * 8 + h) * 16) * 128;
      for (int i = tid; i < 2048; i += 512) km[i] = src[i]; }
    bf16x8 qr[8];
#pragma unroll
    for (int st = 0; st < 8; ++st) qr[st] = *(const bf16x8*)(QA + (size_t)qrow * 1024 + h * 128 + st * 16 + hi * 8);
    TileRegs tr; tile_load(tr, Kh, Vth, 0, tid); tile_store(tr, lds, tid);
    __syncthreads();
    unsigned sel = 0u;
    if (qb > 0) {
        float v1 = -INFINITY, v2 = -INFINITY, v3 = -INFINITY; int i1 = 31, i2 = 31, i3 = 31;
        for (int j = 0; j < qb; ++j) {
            const ATT_LAS float* km = (const ATT_LAS float*)(lds + KM_OFF) + j * 128 + hi * 8;
            float dot = 0.f;
#pragma unroll
            for (int st = 0; st < 8; ++st) { const f32x4 k0 = *(const ATT_LAS f32x4*)(km + st * 16), k1 = *(const ATT_LAS f32x4*)(km + st * 16 + 4);
                const u32x4 qw = __builtin_bit_cast(u32x4, qr[st]);
                dot += __uint_as_float(qw.x << 16) * k0[0] + __uint_as_float(qw.x & 0xffff0000u) * k0[1] + __uint_as_float(qw.y << 16) * k0[2] + __uint_as_float(qw.y & 0xffff0000u) * k0[3]
                     + __uint_as_float(qw.z << 16) * k1[0] + __uint_as_float(qw.z & 0xffff0000u) * k1[1] + __uint_as_float(qw.w << 16) * k1[2] + __uint_as_float(qw.w & 0xffff0000u) * k1[3]; }
            dot += __shfl_xor(dot, 32);
            if (dot > v1) { v3 = v2; i3 = i2; v2 = v1; i2 = i1; v1 = dot; i1 = j; }
            else if (dot > v2) { v3 = v2; i3 = i2; v2 = dot; i2 = j; }
            else if (dot > v3) { v3 = dot; i3 = j; }
        }
        sel = (1u << i1) | (1u << i2) | (1u << i3);
    }
    f32x16 o[4];
#pragma unroll
    for (int db = 0; db < 4; ++db)
#pragma unroll
        for (int r = 0; r < 16; ++r) o[db][r] = 0.f;
    float m = NEG, l = 0.f;
    const int NS = 4 * (qb + 1), ql = wid * 32 + r32;
    for (int i = 0; i < NS; ++i) {
        const int j = i >> 2, t = i & 3;
        if (i + 1 < NS) tile_load(tr, Kh, Vth, (i + 1) * 64, tid);
        const ATT_LAS unsigned char* kb = lds + (i & 1) * BUF; const ATT_LAS unsigned char* vb = kb + KBYTES;
        const bool own = (j == qb);
        if (!own || t <= (wid >> 1)) {
            const bool lane_on = own || ((sel >> j) & 1u);
#pragma unroll 1
            for (int sub = 0; sub < 2; ++sub) {
                f32x16 s;
#pragma unroll
                for (int r = 0; r < 16; ++r) s[r] = 0.f;
#pragma unroll
                for (int st = 0; st < 8; ++st) { const bf16x8 a = *(const ATT_LAS bf16x8*)(kb + (32 * sub + r32) * KROW + (16 * st + 8 * hi) * 2); s = ATT_MFMA(a, qr[st], s); }
                if (own) {
#pragma unroll
                    for (int r = 0; r < 16; ++r) { const int kvl = 64 * t + 32 * sub + crow(r, hi); if (kvl > ql) s[r] = NEG; }
                } else {
#pragma unroll
                    for (int r = 0; r < 16; ++r) s[r] = lane_on ? s[r] : NEG;
                }
                softmax_step(s, m, l, o);
#pragma unroll
                for (int c = 0; c < 2; ++c) { const bf16x8 pb = pack8(s, c);
#pragma unroll
                    for (int db = 0; db < 4; ++db) o[db] = ATT_MFMA(vfrag(vb, db, sub, c, r32, hi), pb, o[db]); }
            }
        }
        if (i + 1 < NS) tile_store(tr, lds + ((i + 1) & 1) * BUF, tid);
        __syncthreads();
    }
    l += __shfl_xor(l, 32);
    const float inv = 1.0f / l;
    bf16_t* yp = YA + (size_t)qrow * 1024 + h * 128 + 4 * hi;
#pragma unroll
    for (int db = 0; db < 4; ++db)
#pragma unroll
        for (int g = 0; g < 4; ++g) { u32x2 w; w.x = cvtpk(o[db][4 * g] * inv, o[db][4 * g + 1] * inv); w.y = cvtpk(o[db][4 * g + 2] * inv, o[db][4 * g + 3] * inv);
            *(u32x2*)(yp + 32 * db + 8 * g) = w; }
}

__device__ __forceinline__ void diff_unit128(int b, int h, int qi, const bf16_t* QB, const bf16_t* KB, const bf16_t* VT, const float* subln_w, float lam, float out_scale, bf16_t* YB, ATT_LAS unsigned char* lds) {
    int tid = threadIdx.x; asm volatile("" : "+v"(tid));
    const int lane = tid & 63, r32 = lane & 31, hi = lane >> 5, wid = __builtin_amdgcn_readfirstlane(tid >> 6), grp = wid >> 2, wrow = wid & 3;
    const bf16_t* Kh = KB + (size_t)b * SEQ * 1024 + h * 128;
    const bf16_t* Vth = VT + (size_t)(1024 + h * 128) * MROWS + (size_t)b * SEQ;
    const int NS = 2 * (qi + 1), ql = wrow * 32 + r32, qrow = b * SEQ + qi * 128 + ql, koff = grp * 64;
    __syncthreads();
    bf16x8 q[4];
#pragma unroll
    for (int st = 0; st < 4; ++st) q[st] = *(const bf16x8*)(QB + (size_t)qrow * 1024 + h * 128 + koff + st * 16 + hi * 8);
    TileRegs tr; tile_load(tr, Kh, Vth, 0, tid); tile_store(tr, lds, tid);
    __syncthreads();
    f32x16 o[4];
#pragma unroll
    for (int db = 0; db < 4; ++db)
#pragma unroll
        for (int r = 0; r < 16; ++r) o[db][r] = 0.f;
    float m = NEG, l = 0.f;
#pragma unroll 1
    for (int i = 0; i < NS; ++i) {
        if (i + 1 < NS) tile_load(tr, Kh, Vth, (i + 1) * 64, tid);
        const ATT_LAS unsigned char* kb = lds + (i & 1) * BUF; const ATT_LAS unsigned char* vb = kb + KBYTES;
        const int t = i - 2 * qi;
        if (t < 0 || t <= (wrow >> 1)) {
#pragma unroll 1
            for (int sub = 0; sub < 2; ++sub) {
                f32x16 s;
#pragma unroll
                for (int r = 0; r < 16; ++r) s[r] = 0.f;
#pragma unroll
                for (int st = 0; st < 4; ++st) s = ATT_MFMA(*(const ATT_LAS bf16x8*)(kb + (32 * sub + r32) * KROW + (koff + 16 * st + 8 * hi) * 2), q[st], s);
                if (t >= 0) {
#pragma unroll
                    for (int r = 0; r < 16; ++r) { const int kvl = 64 * t + 32 * sub + crow(r, hi); if (kvl > ql) s[r] = NEG; }
                }
                softmax_step(s, m, l, o);
#pragma unroll
                for (int c = 0; c < 2; ++c) { const bf16x8 pb = pack8(s, c);
#pragma unroll
                    for (int db = 0; db < 4; ++db) o[db] = ATT_MFMA(vfrag(vb, db, sub, c, r32, hi), pb, o[db]); }
            }
        }
        if (i + 1 < NS) tile_store(tr, lds + ((i + 1) & 1) * BUF, tid);
        __syncthreads();
    }
    l += __shfl_xor(l, 32);
    ATT_LAS float* xs = (ATT_LAS float*)lds + (wrow * 64) * 64 + lane;
    if (grp == 1) {
        const float i2 = lam / l;
#pragma unroll
        for (int db = 0; db < 4; ++db)
#pragma unroll
            for (int r = 0; r < 16; ++r) xs[(db * 16 + r) * 64] = o[db][r] * i2;
    }
    __syncthreads();
    if (grp == 0) {
        const float i1 = 1.0f / l;
        float ss = 0.f;
#pragma unroll
        for (int db = 0; db < 4; ++db)
#pragma unroll
            for (int r = 0; r < 16; ++r) { const float v = o[db][r] * i1 - xs[(db * 16 + r) * 64]; o[db][r] = v; ss += v * v; }
        ss += __shfl_xor(ss, 32);
        const float rs = out_scale / sqrtf(ss * (1.0f / 128.0f) + 1e-5f);
        bf16_t* yp = YB + (size_t)qrow * 1024 + h * 128 + 4 * hi;
#pragma unroll
        for (int db = 0; db < 4; ++db)
#pragma unroll
            for (int g = 0; g < 4; ++g) { const f32x4 w4 = *(const f32x4*)(subln_w + 32 * db + 8 * g + 4 * hi);
                u32x2 w; w.x = cvtpk(o[db][4 * g] * rs * w4[0], o[db][4 * g + 1] * rs * w4[1]); w.y = cvtpk(o[db][4 * g + 2] * rs * w4[2], o[db][4 * g + 3] * rs * w4[3]);
                *(u32x2*)(yp + 32 * db + 8 * g) = w;
                if (g & 1) asm volatile("" ::: "memory"); }
    }
}
}
namespace cg = cooperative_groups;
#ifndef MK_N_LAUNCHES
#define MK_N_LAUNCHES 1
#define MK_DUMP 0
#define MK_DUMP_PH 2
#define MK_DUMP_OFF (WS_R2 + 64 * MiB)
#endif
constexpr int NPHASE = 9;
#ifndef MK_REP_P2
#define MK_REP_P2 1
#endif
#ifndef MK_REP_P0
#define MK_REP_P0 2
#endif
#ifndef MK_REPS
#define MK_REPS 1
#endif
constexpr int NWAVES = 8;
constexpr int M = 8192, DM = 2048, SEQ = 4096, NIN = 8192  , FFH = 5632;
constexpr float LN_EPS = 1e-5f;
constexpr float ALPHA = 1.189207115002721f;
constexpr float SC_A = 0.08838834764831845f * 1.4426950408889634f, SC_B = 0.125f * 1.4426950408889634f;
constexpr float LAM_INIT = 0.2f;

constexpr size_t MiB = 1u << 20;
constexpr size_t WS_WIN = 1 * MiB, WS_WV = 33 * MiB, WS_WBA = 41 * MiB, WS_WBB = 45 * MiB, WS_WOUT = 49 * MiB, WS_WFI = 57 * MiB, WS_WFO = 101 * MiB;
constexpr size_t WS_T128 = 123 * MiB, WS_T64 = 125 * MiB, WS_KM = 126 * MiB;
constexpr size_t WS_R1 = 128 * MiB;
constexpr size_t WS_R2 = 160 * MiB;
constexpr size_t WS_R3 = 288 * MiB;
constexpr size_t WS_END = 320 * MiB;
constexpr int MISC_OFF = 131072, LDS_BYTES = 131072 + 1024;
constexpr size_t WS_CTL = 0, CTL_ZERO_BYTES = 65536;
constexpr int SCHED_N = 4;
__device__ const unsigned char SCHED[32 * SCHED_N] = {15,4,255,255,47,36,255,255,14,76,65,255,46,108,97,255,13,77,0,255,45,109,32,255,12,37,1,255,44,110,68,255,95,5,75,255,127,78,107,255,94,79,74,255,126,111,106,255,11,6,33,255,93,38,100,255,43,80,3,255,125,112,73,255,92,81,35,255,124,113,105,255,91,82,72,255,123,114,104,255,10,39,67,255,42,115,99,255,90,7,71,255,122,83,103,255,89,84,2,255,121,116,34,255,9,8,66,64,88,40,98,96,41,85,70,255,120,117,102,255,87,86,69,255,119,118,101,255};

#define LAS __attribute__((address_space(3)))
typedef unsigned short bf16;
typedef unsigned v4u __attribute__((ext_vector_type(4)));
typedef unsigned v2u __attribute__((ext_vector_type(2)));
typedef float f32x4 __attribute__((ext_vector_type(4)));
__device__ __forceinline__ unsigned f2bf(float f) { unsigned u = __builtin_bit_cast(unsigned, f); return (u + 0x7fffu + ((u >> 16) & 1u)) >> 16; }
__device__ __forceinline__ unsigned pk2(float lo, float hi) { return f2bf(lo) | (f2bf(hi) << 16); }
__device__ __forceinline__ float wave_sum(float v) {
#pragma unroll
    for (int o = 1; o < 64; o <<= 1) v += __shfl_xor(v, o);
    return v;
}
#define XB_TMO      128
#define XB_XCNT(j)  (256  + 64 * (j))
#define XB_XSUB(j)  (1280 + 64 * (j))
#define XB_XGEN(j)  (2304 + 64 * (j))
#define XB_TOP      3328
#define XB_TOPGEN   3392
#define XCD_BAR_WORDS 3456
#define XB_SPIN_CAP (1u << 18)

__device__ __forceinline__ unsigned xb_ld(unsigned* p)              { return __hip_atomic_load(p, __ATOMIC_RELAXED, __HIP_MEMORY_SCOPE_AGENT); }
__device__ __forceinline__ unsigned xb_add(unsigned* p, unsigned v) { return __hip_atomic_fetch_add(p, v, __ATOMIC_RELAXED, __HIP_MEMORY_SCOPE_AGENT); }
__device__ __forceinline__ unsigned xb_xcc_id() { return (unsigned)__builtin_amdgcn_s_getreg((3 << 11) | 20) & 0xFu; }
#define XB_SPIN(cond, bar) do { unsigned _sp = 0; while (cond) { __builtin_amdgcn_s_sleep(1); \
    if ((++_sp & 255u) == 0u) { if (xb_ld(&(bar)[XB_TMO])) break; if (_sp > XB_SPIN_CAP) { atomicAdd(&(bar)[XB_TMO], 1u); break; } } } } while (0)

struct XcdBarrier {
    unsigned* bar; unsigned x;
    volatile LAS unsigned* st;
};

__device__ __forceinline__ XcdBarrier xcd_barrier_post(unsigned* bar, volatile LAS unsigned* st) {
    XcdBarrier b; b.bar = bar; b.x = xb_xcc_id(); b.st = st;
    if (threadIdx.x == 0) (void)xb_add(&bar[XB_XCNT(b.x)], 1u);
    return b;
}
__device__ __forceinline__ void xcd_barrier_complete(unsigned* bar, unsigned x, unsigned& nloc, unsigned& nx) {
    const unsigned G = gridDim.x * gridDim.y * gridDim.z;
    unsigned sum, cnt, mine, sp = 0u;
    for (;;) {
        sum = 0u; cnt = 0u; mine = 0u;
#pragma unroll
        for (unsigned j = 0; j < 16; ++j) { const unsigned c = xb_ld(&bar[XB_XCNT(j)]); sum += c; cnt += (c > 0u) ? 1u : 0u; mine = (j == x) ? c : mine; }
        if (sum == G) break;
        __builtin_amdgcn_s_sleep(1);
        if ((++sp & 255u) == 0u) { if (xb_ld(&bar[XB_TMO])) break; if (sp > XB_SPIN_CAP) { atomicAdd(&bar[XB_TMO], 1u); break; } }
    }
    nloc = mine > 0u ? mine : 1u; nx = cnt > 0u ? cnt : 1u;
}

__device__ __forceinline__ void xcd_barrier(const XcdBarrier& b) {
    asm volatile("s_waitcnt vmcnt(0)" ::: "memory");
    __syncthreads();
    if (threadIdx.x == 0) {
        unsigned* bar = b.bar;
        __builtin_amdgcn_s_waitcnt(0);
        unsigned nloc = b.st[0], nx = b.st[1];
        if (nloc == 0u) { xcd_barrier_complete(bar, b.x, nloc, nx); b.st[0] = nloc; b.st[1] = nx; }
        const unsigned old = xb_add(&bar[XB_XSUB(b.x)], 1u);
        const unsigned gen = old / nloc;
        if (old + 1u == (gen + 1u) * nloc) {
            __builtin_amdgcn_fence(__ATOMIC_RELEASE, "agent");
            asm volatile("s_waitcnt vmcnt(0)" ::: "memory");
            const unsigned og = xb_add(&bar[XB_TOP], 1u);
            const unsigned tg = og / nx;
            if (og + 1u == (tg + 1u) * nx) xb_add(&bar[XB_TOPGEN], 1u);
            else XB_SPIN(xb_ld(&bar[XB_TOPGEN]) == tg, bar);
            __builtin_amdgcn_fence(__ATOMIC_ACQUIRE, "agent");
            xb_add(&bar[XB_XGEN(b.x)], 1u);
            asm volatile("s_waitcnt vmcnt(0)" ::: "memory");
        } else {
            XB_SPIN(xb_ld(&bar[XB_XGEN(b.x)]) == gen, bar);
            __builtin_amdgcn_fence(__ATOMIC_ACQUIRE, "agent");
            asm volatile("s_waitcnt vmcnt(0)" ::: "memory");
        }
    }
    __syncthreads();
}
__device__ __forceinline__ int src_col_in(int g) {
    if (g >= 4096) return g + 2048;
    const int region = g >> 10, h = (g >> 7) & 7, gl = g & 127, e = gl & 7, blk = gl >> 3;
    const int base = region == 0 ? 0 : region == 1 ? 1024 : region == 2 ? 3072 : 4096;
    const int d = region < 2 ? 4 * blk + (e & 3) + 64 * (e >> 2) : (blk >> 3) * 64 + 4 * (blk & 7) + (e & 3) + 32 * (e >> 2);
    return base + h * 128 + d;
}
__device__ __forceinline__ void p0_item(const float* W, int K, int N, int Ndst, bf16* WT, LAS float* scr, int item, int lane, int mode, int src_off) {
    const int nblk = Ndst / 32, kb = item / nblk, nb = item % nblk, k0 = 64 * kb, g0 = 32 * nb;
    const int g = g0 + (lane & 31);
    const int sc = mode == 0 ? src_off + g : (mode == 1 ? src_col_in(g) : ((g >> 7) & 1) * 5632 + 128 * (g >> 8) + (g & 127));
#pragma unroll 8
    for (int i = 0; i < 32; ++i) { const int kk = 2 * i + (lane >> 5); scr[kk * 33 + (lane & 31)] = W[(size_t)(k0 + kk) * N + sc]; }
    asm volatile("s_waitcnt lgkmcnt(0)" ::: "memory");
    const int c = lane & 7;
#pragma unroll
    for (int j = 0; j < 4; ++j) { const int n = (lane >> 3) + 8 * j; const LAS float* s = scr + (8 * c) * 33 + n;
        v4u o; o.x = pk2(s[0 * 33], s[1 * 33]); o.y = pk2(s[2 * 33], s[3 * 33]); o.z = pk2(s[4 * 33], s[5 * 33]); o.w = pk2(s[6 * 33], s[7 * 33]);
        *(v4u*)(WT + (size_t)(g0 + n) * K + k0 + 8 * c) = o; }
    asm volatile("s_waitcnt lgkmcnt(0)" ::: "memory");
}
__device__ __forceinline__ void ln_row(float* row, const float* gam, const float* bet, bf16* brow, int lane) {
    f32x4* xr = (f32x4*)row + lane; f32x4 v[8]; float s = 0.f;
#pragma unroll
    for (int j = 0; j < 8; ++j) { v[j] = xr[64 * j]; s += (v[j].x + v[j].y) + (v[j].z + v[j].w); }
    const float mean = wave_sum(s) * (1.f / 2048.f); float s2 = 0.f;
#pragma unroll
    for (int j = 0; j < 8; ++j) { v[j] = v[j] - mean; s2 += (v[j].x * v[j].x + v[j].y * v[j].y) + (v[j].z * v[j].z + v[j].w * v[j].w); }
    const float rstd = 1.f / sqrtf(wave_sum(s2) * (1.f / 2048.f) + LN_EPS);
#pragma unroll
    for (int j = 0; j < 8; ++j) { const f32x4 g4 = *((const f32x4*)gam + 64 * j + lane), b4 = *((const f32x4*)bet + 64 * j + lane);
        const f32x4 o = v[j] * rstd * g4 + b4; xr[64 * j] = o;
        if (brow) { v2u w; w.x = pk2(o.x, o.y); w.y = pk2(o.z, o.w); *((v2u*)brow + 64 * j + lane) = w; } }
}

struct Args { const float* in[13]; float* out; unsigned char* ws; int ph_lo, ph_hi, coop, pad; };
__global__ void __launch_bounds__(NWAVES * 64, 2) mk_fwd(Args args) {
    extern __shared__ __attribute__((aligned(16))) unsigned char lds_raw[];
    LAS unsigned char* lds = (LAS unsigned char*)lds_raw;
    const int wave = __builtin_amdgcn_readfirstlane(threadIdx.x >> 6);
    const int G = gridDim.x, bx = blockIdx.x, vcu = (G % 8 == 0) ? (bx % 8) * (G / 8) + bx / 8 : bx;
    unsigned char* ws = args.ws;
    const float* x = args.in[0]; const float* w_in = args.in[1]; const float* lambda_qk = args.in[2]; const float* subln_w = args.in[3];
    const float* w_ba = args.in[4]; const float* w_bb = args.in[5]; const float* w_out = args.in[6]; const float* ln1_g = args.in[7]; const float* ln1_b = args.in[8];
    const float* w_fi = args.in[9]; const float* w_fo = args.in[10]; const float* ln2_g = args.in[11]; const float* ln2_b = args.in[12];
    float* out = args.out;
    bf16* WinT = (bf16*)(ws + WS_WIN); bf16* WvT = (bf16*)(ws + WS_WV); bf16* WbaT = (bf16*)(ws + WS_WBA); bf16* WbbT = (bf16*)(ws + WS_WBB);
    bf16* WoutT = (bf16*)(ws + WS_WOUT); bf16* WfiT = (bf16*)(ws + WS_WFI); bf16* WfoT = (bf16*)(ws + WS_WFO);
    float* T128 = (float*)(ws + WS_T128); float* T64 = (float*)(ws + WS_T64); float* kmean = (float*)(ws + WS_KM);
    bf16* XB = (bf16*)(ws + WS_R1); bf16* YA = (bf16*)(ws + WS_R1); bf16* YB = YA + (size_t)M * 1024; bf16* H1B = (bf16*)(ws + WS_R1);
    bf16* QK = (bf16*)(ws + WS_R2); bf16* SG = QK + (size_t)4 * M * 1024; bf16* HID = (bf16*)(ws + WS_R2);
    bf16* VT = (bf16*)(ws + WS_R3); bf16* MB = (bf16*)(ws + WS_R3);
    const int lo = args.ph_lo, hi = args.ph_hi;
#ifdef ONLY_PHASE
#define IN(k) ((k) == ONLY_PHASE && lo <= (k) && (k) < hi)
#else
#define IN(k) (lo <= (k) && (k) < hi)
#endif
#define SEAM(k) do { if (args.coop && IN(k) && IN((k) + 1)) xcd_barrier(bar); } while (0)
    const int gw = vcu * NWAVES + wave, NGW = G * NWAVES, NGT = G * NWAVES * 64;
    volatile LAS unsigned* MISC = (volatile LAS unsigned*)(lds + MISC_OFF);
    if (threadIdx.x < 32) MISC[threadIdx.x] = 0u;
    __syncthreads();
    XcdBarrier bar; bar.bar = (unsigned*)(ws + WS_CTL); bar.x = 0; bar.st = nullptr;
    if (args.coop) bar = xcd_barrier_post((unsigned*)(ws + WS_CTL), MISC + 8);
    if (args.pad == 0x5a5a) cg::this_grid().sync();

    if (IN(0)) {
        const int tid = threadIdx.x, lane = tid & 63, gt = bx * (NWAVES * 64) + tid;
        LAS float* scr = (LAS float*)(lds + wave * 16384);
        constexpr int I_IN = (DM / 64) * (NIN / 32), I_V = (DM / 64) * (2048 / 32), I_BA = (1024 / 64) * (2048 / 32), I_OUT = (DM / 64) * (2048 / 32), I_FI = (DM / 64) * (2 * FFH / 32), I_FO = (FFH / 64) * (2048 / 32);
        constexpr int NITEMS = I_IN + I_V + 2 * I_BA + I_OUT + I_FI + I_FO;
        for (int it = gw; it < NITEMS; it += NGW) {
            int r = it;
            if (r < I_IN) { p0_item(w_in, DM, 10240, NIN, WinT, scr, r, lane, 1, 0); continue; } r -= I_IN;
            if (r < I_V) { const int nblk = 2048 / 32, nb = r % nblk; p0_item(w_in, DM, 10240, 2048, WvT, scr, r, lane, 0, nb < 32 ? 2048 : 5120 - 1024); continue; } r -= I_V;
            if (r < I_BA) { p0_item(w_ba, 1024, 2048, 2048, WbaT, scr, r, lane, 0, 0); continue; } r -= I_BA;
            if (r < I_BA) { p0_item(w_bb, 1024, 2048, 2048, WbbT, scr, r, lane, 0, 0); continue; } r -= I_BA;
            if (r < I_OUT) { p0_item(w_out, DM, 2048, 2048, WoutT, scr, r, lane, 0, 0); continue; } r -= I_OUT;
            if (r < I_FI) { p0_item(w_fi, DM, 2 * FFH, 2 * FFH, WfiT, scr, r, lane, 2, 0); continue; } r -= I_FI;
            p0_item(w_fo, FFH, 2048, 2048, WfoT, scr, r, lane, 0, 0);
        }
        for (int i = gt; i < M * DM / 8; i += NGT) { const f32x4 a = *((const f32x4*)x + 2 * (size_t)i), b = *((const f32x4*)x + 2 * (size_t)i + 1);
            v4u o; o.x = pk2(a.x, a.y); o.y = pk2(a.z, a.w); o.z = pk2(b.x, b.y); o.w = pk2(b.z, b.w); *((v4u*)XB + i) = o; }
        for (int i = gt; i < SEQ * 96; i += NGT) {
            int pos, f, half; float* tab;
            if (i < SEQ * 64) { pos = i >> 6; f = i & 63; half = 64; tab = T128; } else { const int k = i - SEQ * 64; pos = k >> 5; f = k & 31; half = 32; tab = T64; }
            const float inv_freq = (float)exp2(-(double)f / (double)half * 13.287712379549449);
            const float ang = (float)pos * inv_freq;
            double tt = (double)ang * 0.15915494309189535; tt -= floor(tt);
            tab[(size_t)pos * half + f] = __builtin_amdgcn_cosf((float)tt); tab[(size_t)(SEQ + pos) * half + f] = __builtin_amdgcn_sinf((float)tt);
        }
        for (int i = gt; i < 2 * 8 * 16 * 128; i += NGT) kmean[i] = 0.f;
    }
    SEAM(0);
    if (IN(1)) {
        { pg8::Gemm g{XB, WinT, M, NIN, DM}; pg8::StaticOrder S; S.init(M, NIN, G, bx);
          pg8::EpiIn E{QK, SG, T128, T64, kmean, SC_A, SC_B};
          pg8::gemm_phase<pg8::EpiIn, pg8::StaticOrder, true, true>(lds, g, S, E); }
        { pg8::Gemm g{WvT, XB, 2048, M, DM}; pg8::StaticOrder S; S.init(2048, M, G, bx);
          pg8::EpiStore E{VT, M};
          pg8::gemm_phase<pg8::EpiStore, pg8::StaticOrder, true, true>(lds, g, S, E); }
    }
    SEAM(1);
    if (IN(2)) {
        const int lane = threadIdx.x & 63;
        float sa = 0.f, sb = 0.f;
        { const float a = lambda_qk[lane] * lambda_qk[64 + lane], b = lambda_qk[128 + lane] * lambda_qk[192 + lane]; sa = wave_sum(a); sb = wave_sum(b); }
        const float lam = expf(sa) - expf(sb) + LAM_INIT;
        for (int v = vcu; v < 256; v += G) {
            const int xcd = v >> 5, cu = v & 31;
            for (int k = 0; k < SCHED_N; ++k) {
                const int code = SCHED[cu * SCHED_N + k];
                if (code == 255) break;
                const int bh = 2 * xcd + ((code >> 5) & 1), b = bh >> 3, h = bh & 7, idx = code & 31;
                if (code < 64) att::moba_unit(b, h, idx, QK, QK + (size_t)M * 1024, VT, kmean, YA, lds);
                else att::diff_unit128(b, h, idx, QK + (size_t)2 * M * 1024, QK + (size_t)3 * M * 1024, VT, subln_w, lam, 1.0f - LAM_INIT, YB, lds);
            }
        }
        __syncthreads();
    }
    SEAM(2);
    if (IN(3)) {
        { pg8::Gemm g{YA, WbaT, M, DM, 1024}; pg8::StaticOrder S; S.init(M, DM, G, bx);
          pg8::EpiBrA E{out, SG};
          pg8::gemm_phase<pg8::EpiBrA, pg8::StaticOrder, true, true>(lds, g, S, E); }
        { pg8::Gemm g{YB, WbbT, M, DM, 1024}; pg8::StaticOrder S; S.init(M, DM, G, bx);
          pg8::EpiBrB E{out, SG, MB};
          pg8::gemm_phase<pg8::EpiBrB, pg8::StaticOrder, true, true>(lds, g, S, E); }
    }
    SEAM(3);
    if (IN(4)) {
        pg8::Gemm g{MB, WoutT, M, DM, DM}; pg8::StaticOrder S; S.init(M, DM, G, bx);
        pg8::EpiRes E{x, out, ALPHA};
        pg8::gemm_phase<pg8::EpiRes, pg8::StaticOrder, true, true>(lds, g, S, E);
    }
    SEAM(4);
    if (IN(5)) { const int lane = threadIdx.x & 63; for (int m = gw; m < M; m += NGW) ln_row(out + (size_t)m * DM, ln1_g, ln1_b, H1B + (size_t)m * DM, lane); }
    SEAM(5);
    if (IN(6)) {
        pg8::Gemm g{H1B, WfiT, M, 2 * FFH, DM}; pg8::StaticOrder S; S.init(M, 2 * FFH, G, bx);
        pg8::EpiSwiglu E{HID};
        pg8::gemm_phase<pg8::EpiSwiglu, pg8::StaticOrder, true, true>(lds, g, S, E);
    }
    SEAM(6);
    if (IN(7)) {
        pg8::Gemm g{HID, WfoT, M, DM, FFH}; pg8::StaticOrder S; S.init(M, DM, G, bx);
        pg8::EpiRes E{out, out, ALPHA};
        pg8::gemm_phase<pg8::EpiRes, pg8::StaticOrder, true, true>(lds, g, S, E);
    }
    SEAM(7);
    if (IN(8)) { const int lane = threadIdx.x & 63; for (int m = gw; m < M; m += NGW) ln_row(out + (size_t)m * DM, ln2_g, ln2_b, nullptr, lane); }
#undef IN
#undef SEAM
}

__global__ void dump_sum4(const unsigned short* a, const unsigned short* b, const unsigned short* c, const unsigned short* d, float* out, int n) {
    for (int i = blockIdx.x * blockDim.x + threadIdx.x; i < n; i += gridDim.x * blockDim.x)
        out[i] = __uint_as_float((unsigned)a[i] << 16) + __uint_as_float((unsigned)b[i] << 16) + __uint_as_float((unsigned)c[i & (2097152 - 1)] << 16) + __uint_as_float((unsigned)d[i & (2097152 - 1)] << 16); }
__global__ void dump_bf16(const unsigned short* src, float* out, int n) { for (int i = blockIdx.x * blockDim.x + threadIdx.x; i < n; i += gridDim.x * blockDim.x) out[i] = __uint_as_float((unsigned)src[i] << 16); }
#ifndef MK_DUMP
#define MK_DUMP 0
#endif
#ifndef MK_DUMP_PH
#define MK_DUMP_PH 3
#define MK_DUMP_OFF WS_R1
#endif
extern "C" void kernel_launch(void* const* d_in, const int* in_sizes, int n_in, void* d_out, int out_size, void* d_ws, size_t ws_size, hipStream_t stream) {
    static int grid = 0;
    if (grid == 0) {
        if (n_in != 13 || in_sizes[0] != M * DM || out_size != M * DM || ws_size < WS_END) { fprintf(stderr, "kernel_launch: unexpected shapes (n_in %d, in0 %d, out %d, ws %zu); nothing launched\n", n_in, n_in > 0 ? in_sizes[0] : -1, out_size, ws_size); grid = -1; return; }
        int dev = 0, cus = 0, per_cu = 0;
        if (hipGetDevice(&dev) != hipSuccess || hipDeviceGetAttribute(&cus, hipDeviceAttributeMultiprocessorCount, dev) != hipSuccess) { grid = -1; return; }
        if (hipFuncSetAttribute((const void*)mk_fwd, hipFuncAttributeMaxDynamicSharedMemorySize, LDS_BYTES) != hipSuccess) { fprintf(stderr, "kernel_launch: hipFuncSetAttribute failed\n"); grid = -1; return; }
        if (hipOccupancyMaxActiveBlocksPerMultiprocessor(&per_cu, (const void*)mk_fwd, NWAVES * 64, LDS_BYTES) != hipSuccess || per_cu < 1) { fprintf(stderr, "kernel_launch: occupancy query gave %d\n", per_cu); per_cu = 1; }
        (void)hipGetLastError();
        grid = cus * per_cu; if (grid > 256) grid = 256;
        grid -= grid % 8; if (grid < 8) grid = 8;
    }
    if (grid < 0) return;
    if (hipMemsetAsync((char*)d_ws + WS_CTL, 0, CTL_ZERO_BYTES, stream) != hipSuccess) { fprintf(stderr, "kernel_launch: hipMemsetAsync failed\n"); return; }
    Args a{};
    for (int i = 0; i < 13; ++i) a.in[i] = (const float*)d_in[i];
    a.out = (float*)d_out; a.ws = (unsigned char*)d_ws;
    if (MK_N_LAUNCHES == 1) {
        a.ph_lo = 0; a.ph_hi = NPHASE; a.coop = 1;
        void* kargs[] = {&a};
        const hipError_t e = hipLaunchCooperativeKernel((const void*)mk_fwd, dim3(grid), dim3(NWAVES * 64), kargs, LDS_BYTES, stream);
        if (e != hipSuccess) fprintf(stderr, "kernel_launch: cooperative launch failed: %s (grid %d)\n", hipGetErrorString(e), grid);
    } else {
        const int lastp = MK_DUMP == 0 ? NPHASE : MK_DUMP_PH;
        for (int rep = 0; rep < MK_REPS; ++rep) for (int p = 0; p < lastp; ++p) { a.ph_lo = p; a.ph_hi = p + 1; a.coop = 0;
            hipLaunchKernelGGL(mk_fwd, dim3(grid), dim3(NWAVES * 64), LDS_BYTES, stream, a); }
        if (MK_DUMP == 2) { hipLaunchKernelGGL(dump_sum4, dim3(2048), dim3(256), 0, stream, (const unsigned short*)((const char*)d_ws + WS_R2 + 64 * MiB), (const unsigned short*)((const char*)d_ws + WS_R2 + 96 * MiB),
            (const unsigned short*)((const char*)d_ws + WS_WBA), (const unsigned short*)((const char*)d_ws + WS_WBB), (float*)d_out, M * DM); }
        else if (MK_DUMP) { hipLaunchKernelGGL(dump_bf16, dim3(2048), dim3(256), 0, stream, (const unsigned short*)((const char*)d_ws + MK_DUMP_OFF), (float*)d_out, M * DM); }
    }
}
```

```cpp
#include <hip/hip_runtime.h>
#include <hip/hip_cooperative_groups.h>
#include <cstdio>
#include <cstdint>
#include <cmath>
namespace pg8 {
#define PG8_LAS __attribute__((address_space(3)))
typedef unsigned short bf16_t;
typedef short bf16x8 __attribute__((ext_vector_type(8)));
typedef float f32x4 __attribute__((ext_vector_type(4)));
typedef unsigned u32x4 __attribute__((ext_vector_type(4)));
constexpr int BM = 256, BK = 64, HALF = 128, HTB = HALF * BK * 2  , STAGE_BYTES = 8 * HTB, NXCD = 8, WGM = 8;

__host__ __device__ __forceinline__ int lds_byte(int r, int c) { const int st = (r >> 4) * 2 + (c >> 5), rr = r & 15, cc = c & 31, ob = rr * 64 + cc * 2; return st * 1024 + (ob ^ (((ob >> 9) & 1) << 5)); }
__host__ __device__ __forceinline__ void stage_rc(int b, int& R, int& C) { const int st = b / 1024, sb = b % 1024, swz = sb ^ (((sb >> 9) & 1) << 5); R = (st >> 1) * 16 + swz / 64; C = (st & 1) * 32 + (swz % 64) / 2; }
__host__ __device__ __forceinline__ int perm32(int rho) { const int n = rho >> 4, i = rho & 15; return 8 * (i >> 2) + 4 * n + (i & 3); }

struct Unit { int pm, pn; };
struct Gemm { const bf16_t* A; const bf16_t* Bt; int M, N, K; };

struct StaticOrder {
    int nM, nN, nwg, G, c;
    __host__ __device__ void init(int M, int N, int G_, int c_) { nM = M / BM; nN = N / BM; nwg = nM * nN; G = G_; c = c_; }
    __host__ __device__ bool next(int i, Unit& u) const {
        const long L = (long)i * G + c; if (L >= nwg) return false;
        int wgid = (int)L; { const int q = nwg / NXCD, r = nwg % NXCD, xcd = wgid % NXCD, off = wgid / NXCD; wgid = (xcd < r ? xcd * (q + 1) : r * (q + 1) + (xcd - r) * q) + off; }
        const int nig = WGM * nN, gid = wgid / nig, fm = gid * WGM, gsz = (nM - fm) < WGM ? (nM - fm) : WGM;
        u.pm = fm + ((wgid % nig) % gsz); u.pn = (wgid % nig) / gsz; return true;
    }
    __device__ __forceinline__ void a_ready(const Unit&) const {}
    __device__ __forceinline__ void done(const Unit&) const {}
};

typedef float f32x2c_t __attribute__((ext_vector_type(2))); typedef __bf16 bf16x2c_t __attribute__((ext_vector_type(2)));
__device__ __forceinline__ unsigned cvt_pk_bf16(float lo, float hi) { f32x2c_t v = {lo, hi}; bf16x2c_t b = __builtin_convertvector(v, bf16x2c_t); return __builtin_bit_cast(unsigned, b); }
typedef float f32x2 __attribute__((ext_vector_type(2)));
typedef unsigned u32x2 __attribute__((ext_vector_type(2)));
__device__ __forceinline__ float fast_sigmoid(float v) { return __builtin_amdgcn_rcpf(1.0f + __builtin_amdgcn_exp2f(-1.4426950408889634f * v)); }
__device__ __forceinline__ float bf_lo(unsigned w) { return __uint_as_float(w << 16); }
__device__ __forceinline__ float bf_hi(unsigned w) { return __uint_as_float(w & 0xffff0000u); }

struct EpiStore {
    static constexpr bool PERM = true, AFTER_DRAIN = false;
    bf16_t* O; int ldc;
    __device__ __forceinline__ void operator()(const f32x4 (&acc)[2][2][4][2], const Unit& u, int wr, int wc, int fr, int fq) const {
        const int row0 = u.pm * BM + wr * 64 + fr, col0 = u.pn * BM + wc * 32 + 8 * fq;
#pragma unroll
        for (int ai = 0; ai < 2; ++ai)
#pragma unroll
            for (int m = 0; m < 4; ++m) { bf16_t* rowp = O + (size_t)(row0 + ai * HALF + m * 16) * ldc + col0;
#pragma unroll
                for (int bj = 0; bj < 2; ++bj) { const f32x4 v0 = acc[ai][bj][m][0], v1 = acc[ai][bj][m][1];
                    u32x4 w; w.x = cvt_pk_bf16(v0[0], v0[1]); w.y = cvt_pk_bf16(v0[2], v0[3]); w.z = cvt_pk_bf16(v1[0], v1[1]); w.w = cvt_pk_bf16(v1[2], v1[3]);
                    *(u32x4*)(rowp + bj * HALF) = w; } }
    }
};

struct EpiIn {
    static constexpr bool PERM = true, AFTER_DRAIN = false;
    bf16_t* QK;
    bf16_t* SG;
    const float* T128;
    const float* T64;
    float* kmean;
    float scA, scB;
    __device__ __forceinline__ void operator()(const f32x4 (&acc)[2][2][4][2], const Unit& u, int wr, int wc, int fr, int fq) const {
        const int pn = u.pn, row0 = u.pm * BM + wr * 64 + fr;
        if (pn >= 16) {
            const int col0 = (pn - 16) * BM + wc * 32 + 8 * fq;
#pragma unroll
            for (int ai = 0; ai < 2; ++ai)
#pragma unroll
                for (int m = 0; m < 4; ++m) { bf16_t* rowp = SG + (size_t)(row0 + ai * HALF + m * 16) * 4096 + col0;
#pragma unroll
                    for (int bj = 0; bj < 2; ++bj) { const f32x4 v0 = acc[ai][bj][m][0], v1 = acc[ai][bj][m][1];
                        u32x4 w; w.x = cvt_pk_bf16(fast_sigmoid(v0[0]), fast_sigmoid(v0[1])); w.y = cvt_pk_bf16(fast_sigmoid(v0[2]), fast_sigmoid(v0[3]));
                        w.z = cvt_pk_bf16(fast_sigmoid(v1[0]), fast_sigmoid(v1[1])); w.w = cvt_pk_bf16(fast_sigmoid(v1[2]), fast_sigmoid(v1[3]));
                        *(u32x4*)(rowp + bj * HALF) = w; } }
            return;
        }
        const int region = pn >> 2; const bool is64 = region >= 2;
        const float sc = region == 0 ? scA : (region == 2 ? scB : 1.0f);
        const int half = is64 ? 32 : 64;
        const int d0 = is64 ? 4 * (4 * (wc & 1) + fq) : 4 * (4 * wc + fq);
        const int cin = is64 ? (wc >> 1) * 64 + d0 : d0;
        const float* tab = is64 ? T64 : T128;
        bf16_t* base = QK + (size_t)region * ((size_t)8192 * 1024) + (pn & 3) * 256 + cin;
#pragma unroll
        for (int ai = 0; ai < 2; ++ai)
#pragma unroll
            for (int m = 0; m < 4; ++m) { const int row = row0 + ai * HALF + m * 16, pos = row & 4095;
                const f32x4 cv = *(const f32x4*)(tab + (size_t)pos * half + d0), sv = *(const f32x4*)(tab + (size_t)(4096 + pos) * half + d0);
                bf16_t* rowp = base + (size_t)row * 1024;
#pragma unroll
                for (int bj = 0; bj < 2; ++bj) { const f32x4 x1 = acc[ai][bj][m][0], x2 = acc[ai][bj][m][1];
                    const f32x4 o1 = (x1 * cv - x2 * sv) * sc, o2 = (x2 * cv + x1 * sv) * sc;
                    u32x2 w1, w2; w1.x = cvt_pk_bf16(o1[0], o1[1]); w1.y = cvt_pk_bf16(o1[2], o1[3]); w2.x = cvt_pk_bf16(o2[0], o2[1]); w2.y = cvt_pk_bf16(o2[2], o2[3]);
                    *(u32x2*)(rowp + bj * HALF) = w1; *(u32x2*)(rowp + bj * HALF + half) = w2;
                    }
                asm volatile("" ::: "memory"); }
        if (region == 1) {
            f32x4 ks[2][2];
#pragma unroll
            for (int bj = 0; bj < 2; ++bj) { ks[bj][0] = (f32x4){0.f, 0.f, 0.f, 0.f}; ks[bj][1] = (f32x4){0.f, 0.f, 0.f, 0.f}; }
#pragma unroll
            for (int ai = 0; ai < 2; ++ai)
#pragma unroll
                for (int m = 0; m < 4; ++m) { const int row = row0 + ai * HALF + m * 16, pos = row & 4095;
                    const f32x4 cv = *(const f32x4*)(tab + (size_t)pos * half + d0), sv = *(const f32x4*)(tab + (size_t)(4096 + pos) * half + d0);
#pragma unroll
                    for (int bj = 0; bj < 2; ++bj) { const f32x4 x1 = acc[ai][bj][m][0], x2 = acc[ai][bj][m][1];
                        ks[bj][0] += x1 * cv - x2 * sv; ks[bj][1] += x2 * cv + x1 * sv; }
                    asm volatile("" ::: "memory"); }
#pragma unroll
            for (int bj = 0; bj < 2; ++bj)
#pragma unroll
                for (int n = 0; n < 2; ++n)
#pragma unroll
                    for (int j = 0; j < 4; ++j) { float v = ks[bj][n][j]; v += __shfl_xor(v, 1); v += __shfl_xor(v, 2); v += __shfl_xor(v, 4); v += __shfl_xor(v, 8); ks[bj][n][j] = v; }
            if (fr == 0) { const int b = u.pm >> 4, blk = u.pm & 15;
#pragma unroll
                for (int bj = 0; bj < 2; ++bj) { float* kp = kmean + ((size_t)((b * 8 + (pn & 3) * 2 + bj) * 16 + blk)) * 128 + d0;
#pragma unroll
                    for (int n = 0; n < 2; ++n)
#pragma unroll
                        for (int j = 0; j < 4; ++j) atomicAdd(kp + n * 64 + j, ks[bj][n][j] * (1.0f / 256.0f)); } }
        }
    }
};

struct EpiBrA {
    static constexpr bool PERM = true, AFTER_DRAIN = false;
    float* T; const bf16_t* SG;
    __device__ __forceinline__ void operator()(const f32x4 (&acc)[2][2][4][2], const Unit& u, int wr, int wc, int fr, int fq) const {
        const int row0 = u.pm * BM + wr * 64 + fr, col0 = u.pn * BM + wc * 32 + 8 * fq;
#pragma unroll
        for (int ai = 0; ai < 2; ++ai)
#pragma unroll
            for (int m = 0; m < 4; ++m) { const size_t row = (size_t)(row0 + ai * HALF + m * 16);
#pragma unroll
                for (int bj = 0; bj < 2; ++bj) { const u32x4 s = *(const u32x4*)(SG + row * 4096 + col0 + bj * HALF);
                    const f32x4 v0 = acc[ai][bj][m][0], v1 = acc[ai][bj][m][1];
                    f32x4 t0, t1; t0[0] = bf_lo(s.x) * v0[0]; t0[1] = bf_hi(s.x) * v0[1]; t0[2] = bf_lo(s.y) * v0[2]; t0[3] = bf_hi(s.y) * v0[3];
                    t1[0] = bf_lo(s.z) * v1[0]; t1[1] = bf_hi(s.z) * v1[1]; t1[2] = bf_lo(s.w) * v1[2]; t1[3] = bf_hi(s.w) * v1[3];
                    float* tp = T + row * 2048 + col0 + bj * HALF; *(f32x4*)tp = t0; *(f32x4*)(tp + 4) = t1; } }
    }
};
struct EpiBrB {
    static constexpr bool PERM = true, AFTER_DRAIN = false;
    const float* T; const bf16_t* SG; bf16_t* MB;
    __device__ __forceinline__ void operator()(const f32x4 (&acc)[2][2][4][2], const Unit& u, int wr, int wc, int fr, int fq) const {
        const int row0 = u.pm * BM + wr * 64 + fr, col0 = u.pn * BM + wc * 32 + 8 * fq;
#pragma unroll
        for (int ai = 0; ai < 2; ++ai)
#pragma unroll
            for (int m = 0; m < 4; ++m) { const size_t row = (size_t)(row0 + ai * HALF + m * 16);
#pragma unroll
                for (int bj = 0; bj < 2; ++bj) { const u32x4 s = *(const u32x4*)(SG + row * 4096 + 2048 + col0 + bj * HALF);
                    const float* tp = T + row * 2048 + col0 + bj * HALF; const f32x4 a0 = *(const f32x4*)tp, a1 = *(const f32x4*)(tp + 4);
                    const f32x4 v0 = acc[ai][bj][m][0], v1 = acc[ai][bj][m][1];
                    u32x4 w; w.x = cvt_pk_bf16(a0[0] + bf_lo(s.x) * v0[0], a0[1] + bf_hi(s.x) * v0[1]); w.y = cvt_pk_bf16(a0[2] + bf_lo(s.y) * v0[2], a0[3] + bf_hi(s.y) * v0[3]);
                    w.z = cvt_pk_bf16(a1[0] + bf_lo(s.z) * v1[0], a1[1] + bf_hi(s.z) * v1[1]); w.w = cvt_pk_bf16(a1[2] + bf_lo(s.w) * v1[2], a1[3] + bf_hi(s.w) * v1[3]);
                    *(u32x4*)(MB + row * 2048 + col0 + bj * HALF) = w; } }
    }
};
struct EpiRes {
    static constexpr bool PERM = false, AFTER_DRAIN = false;
    const float* base; float* out; float alpha;
    __device__ __forceinline__ void operator()(const f32x4 (&acc)[2][2][4][2], const Unit& u, int wr, int wc, int fr, int fq) const {
        const int row0 = u.pm * BM + wr * 64 + fr, col0 = u.pn * BM + wc * 32 + 4 * fq;
#pragma unroll
        for (int ai = 0; ai < 2; ++ai)
#pragma unroll
            for (int m = 0; m < 4; ++m) { const size_t off = (size_t)(row0 + ai * HALF + m * 16) * 2048 + col0;
#pragma unroll
                for (int bj = 0; bj < 2; ++bj)
#pragma unroll
                    for (int n = 0; n < 2; ++n) { const f32x4 b = *(const f32x4*)(base + off + bj * HALF + n * 16); *(f32x4*)(out + off + bj * HALF + n * 16) = b * alpha + acc[ai][bj][m][n]; } }
    }
};
struct EpiSwiglu {
    static constexpr bool PERM = true, AFTER_DRAIN = false;
    bf16_t* H;
    __device__ __forceinline__ void operator()(const f32x4 (&acc)[2][2][4][2], const Unit& u, int wr, int wc, int fr, int fq) const {
        const int row0 = u.pm * BM + wr * 64 + fr, col0 = u.pn * HALF + wc * 32 + 8 * fq;
#pragma unroll
        for (int ai = 0; ai < 2; ++ai)
#pragma unroll
            for (int m = 0; m < 4; ++m) { const f32x4 g0 = acc[ai][0][m][0], g1 = acc[ai][0][m][1], u0 = acc[ai][1][m][0], u1 = acc[ai][1][m][1];
                f32x4 h0, h1;
#pragma unroll
                for (int j = 0; j < 4; ++j) { h0[j] = g0[j] * fast_sigmoid(g0[j]) * u0[j]; h1[j] = g1[j] * fast_sigmoid(g1[j]) * u1[j]; }
                u32x4 w; w.x = cvt_pk_bf16(h0[0], h0[1]); w.y = cvt_pk_bf16(h0[2], h0[3]); w.z = cvt_pk_bf16(h1[0], h1[1]); w.w = cvt_pk_bf16(h1[2], h1[3]);
                *(u32x4*)(H + (size_t)(row0 + ai * HALF + m * 16) * 5632 + col0) = w; }
    }
};
template <class Epi, class Sched, bool ALIGN_EPI = false, bool SP2 = false>
__device__ __forceinline__ void gemm_phase(PG8_LAS unsigned char* lds, const Gemm g, const Sched& S, const Epi& E) {
    const int tid = threadIdx.x, wid = __builtin_amdgcn_readfirstlane(tid >> 6), lane = tid & 63, wr = wid >> 2, wc = wid & 3, fr = lane & 15, fq = lane >> 4;
    const int K = g.K, nt = K / BK;
    unsigned voffA[2], voffB[2];
#pragma unroll
    for (int i = 0; i < 2; ++i) { int R, C; stage_rc(tid * 16 + i * 8192, R, C); const int Rb = Epi::PERM ? ((R & ~31) + perm32(R & 31)) : R;
        voffA[i] = (unsigned)(R * K + C) * 2u; voffB[i] = (unsigned)(Rb * K + C) * 2u; }
    const size_t kstep = (size_t)(BK * 2);
    const size_t hstep = (size_t)HALF * K * 2;
    const size_t tstep = 2 * hstep;
    const unsigned ldsw = (unsigned)wid * 1024u;
    const int aoff = lds_byte(wr * 64 + fr, fq * 8), boff = lds_byte(wc * 32 + fr, fq * 8);
#define PG8_SA(b, h) (((b) * 2 + (h)) * HTB)
#define PG8_SB(b, h) ((4 + (b) * 2 + (h)) * HTB)
#define PG8_STAGE(bufoff, gbase, voff) do { _Pragma("unroll") for (int _i = 0; _i < 2; ++_i) \
        __builtin_amdgcn_global_load_lds((const unsigned*)((const char*)(gbase) + (voff)[_i]), (PG8_LAS unsigned*)(lds + (bufoff) + ldsw + _i * 8192), 16, 0, 0); } while (0)
#define PG8_LDA(dst, b, h) do { _Pragma("unroll") for (int m = 0; m < 4; ++m) _Pragma("unroll") for (int k = 0; k < 2; ++k) dst[m][k] = *(const PG8_LAS bf16x8*)(lds + PG8_SA(b, h) + aoff + m * 2048 + k * 1024); } while (0)
#define PG8_LDB(dst, b, h) do { _Pragma("unroll") for (int n = 0; n < 2; ++n) _Pragma("unroll") for (int k = 0; k < 2; ++k) dst[n][k] = *(const PG8_LAS bf16x8*)(lds + PG8_SB(b, h) + boff + n * 2048 + k * 1024); } while (0)
#define PG8_MMA(ai, bj, At, Bt) do { __builtin_amdgcn_s_setprio(1); _Pragma("unroll") for (int m = 0; m < 4; ++m) _Pragma("unroll") for (int n = 0; n < 2; ++n) _Pragma("unroll") for (int k = 0; k < 2; ++k) \
        acc[ai][bj][m][n] = __builtin_amdgcn_mfma_f32_16x16x32_bf16(Bt[n][k], At[m][k], acc[ai][bj][m][n], 0, 0, 0); __builtin_amdgcn_s_setprio(0); } while (0)
#define PG8_WAIT_V(n) asm volatile("s_waitcnt vmcnt(" #n ")" ::: "memory")
#define PG8_WAIT_L(n) asm volatile("s_waitcnt lgkmcnt(" #n ")" ::: "memory")
#define PG8_BAR __builtin_amdgcn_s_barrier()
#define PG8_SCHED __builtin_amdgcn_sched_barrier(0)
    Unit cur, nxt; int ui = 0;
    if (!S.next(0, cur)) return;
    f32x4 acc[2][2][4][2];
#pragma unroll
    for (int a = 0; a < 2; ++a)
#pragma unroll
        for (int b = 0; b < 2; ++b)
#pragma unroll
            for (int m = 0; m < 4; ++m)
#pragma unroll
                for (int n = 0; n < 2; ++n) acc[a][b][m][n] = (f32x4){0.f, 0.f, 0.f, 0.f};
    bf16x8 At[4][2], B0[2][2], B1[2][2];
    const char* cA = (const char*)g.A + (size_t)cur.pm * tstep; const char* cB = (const char*)g.Bt + (size_t)cur.pn * tstep;
    S.a_ready(cur);
    if constexpr (SP2) {
        PG8_STAGE(PG8_SB(0, 0), cB, voffB); PG8_STAGE(PG8_SB(0, 1), cB + hstep, voffB); PG8_STAGE(PG8_SA(0, 0), cA, voffA); PG8_STAGE(PG8_SA(0, 1), cA + hstep, voffA);
        if (wr == 1) PG8_BAR;
        PG8_WAIT_V(2); PG8_BAR;
        PG8_STAGE(PG8_SB(1, 0), cB + kstep, voffB); PG8_STAGE(PG8_SA(1, 0), cA + kstep, voffA); PG8_STAGE(PG8_SB(1, 1), cB + hstep + kstep, voffB);
        PG8_WAIT_V(6); PG8_BAR;
    } else {
        PG8_STAGE(PG8_SB(0, 0), cB, voffB); PG8_STAGE(PG8_SA(0, 0), cA, voffA); PG8_STAGE(PG8_SB(0, 1), cB + hstep, voffB); PG8_STAGE(PG8_SA(0, 1), cA + hstep, voffA);
        if (wr == 1) PG8_BAR;
        PG8_WAIT_V(4); PG8_BAR;
        PG8_STAGE(PG8_SB(1, 0), cB + kstep, voffB); PG8_STAGE(PG8_SA(1, 0), cA + kstep, voffA); PG8_STAGE(PG8_SB(1, 1), cB + hstep + kstep, voffB);
        PG8_WAIT_V(6); PG8_BAR;
    }
    for (;;) {
        const bool has_next = S.next(ui + 1, nxt);
        const char* nA = has_next ? (const char*)g.A + (size_t)nxt.pm * tstep : cA; const char* nB = has_next ? (const char*)g.Bt + (size_t)nxt.pn * tstep : cB;
        for (int t = 0; t < nt; t += 2) {
            const bool last = (t == nt - 2);
            const char* a1 = cA + (size_t)(t + 1) * kstep;
            const char* a2 = last ? nA : cA + (size_t)(t + 2) * kstep; const char* b2 = last ? nB : cB + (size_t)(t + 2) * kstep;
            const char* a3 = a2 + kstep; const char* b3 = b2 + kstep;
            if (last && has_next) S.a_ready(nxt);
            if constexpr (SP2) {
            PG8_LDB(B0, 0, 0); PG8_LDB(B1, 0, 1); PG8_SCHED; PG8_LDA(At, 0, 0); PG8_STAGE(PG8_SA(1, 1), a1 + hstep, voffA);
            PG8_WAIT_V(8); PG8_WAIT_L(0); PG8_BAR; PG8_MMA(0, 0, At, B0); PG8_MMA(0, 1, At, B1); PG8_BAR; PG8_SCHED;
            PG8_LDA(At, 0, 1); PG8_STAGE(PG8_SB(0, 0), b2, voffB); PG8_STAGE(PG8_SB(0, 1), b2 + hstep, voffB); PG8_STAGE(PG8_SA(0, 0), a2, voffA);
            PG8_WAIT_V(8); PG8_WAIT_L(0); PG8_BAR; PG8_MMA(1, 0, At, B0); PG8_MMA(1, 1, At, B1); PG8_BAR; PG8_SCHED;
            PG8_LDB(B0, 1, 0); PG8_LDB(B1, 1, 1); PG8_SCHED; PG8_LDA(At, 1, 0); PG8_STAGE(PG8_SA(0, 1), a2 + hstep, voffA);
            PG8_WAIT_V(8); PG8_WAIT_L(0); PG8_BAR; PG8_MMA(0, 0, At, B0); PG8_MMA(0, 1, At, B1); PG8_BAR; PG8_SCHED;
            PG8_LDA(At, 1, 1); PG8_STAGE(PG8_SB(1, 0), b3, voffB); PG8_STAGE(PG8_SB(1, 1), b3 + hstep, voffB); PG8_STAGE(PG8_SA(1, 0), a3, voffA);
            PG8_WAIT_V(8); PG8_WAIT_L(0); PG8_BAR; PG8_MMA(1, 0, At, B0); PG8_MMA(1, 1, At, B1); PG8_BAR; PG8_SCHED;
            } else {
            PG8_LDB(B0, 0, 0); PG8_SCHED; PG8_LDA(At, 0, 0); PG8_STAGE(PG8_SA(1, 1), a1 + hstep, voffA);
            PG8_WAIT_L(8); PG8_BAR; PG8_WAIT_L(0); PG8_MMA(0, 0, At, B0); PG8_BAR; PG8_SCHED;
            PG8_LDB(B1, 0, 1); PG8_STAGE(PG8_SB(0, 0), b2, voffB);
            PG8_BAR; PG8_WAIT_L(0); PG8_MMA(0, 1, At, B1); PG8_BAR;
            PG8_LDA(At, 0, 1); PG8_STAGE(PG8_SA(0, 0), a2, voffA);
            PG8_BAR; PG8_WAIT_L(0); PG8_MMA(1, 0, At, B0); PG8_BAR; PG8_SCHED;
            PG8_STAGE(PG8_SB(0, 1), b2 + hstep, voffB);
            PG8_WAIT_V(6); PG8_BAR; PG8_MMA(1, 1, At, B1); PG8_BAR;
            PG8_LDB(B0, 1, 0); PG8_SCHED; PG8_LDA(At, 1, 0); PG8_STAGE(PG8_SA(0, 1), a2 + hstep, voffA);
            PG8_WAIT_L(8); PG8_BAR; PG8_WAIT_L(0); PG8_MMA(0, 0, At, B0); PG8_BAR; PG8_SCHED;
            PG8_LDB(B1, 1, 1); PG8_STAGE(PG8_SB(1, 0), b3, voffB);
            PG8_BAR; PG8_WAIT_L(0); PG8_MMA(0, 1, At, B1); PG8_BAR;
            PG8_LDA(At, 1, 1); PG8_STAGE(PG8_SA(1, 0), a3, voffA);
            PG8_BAR; PG8_WAIT_L(0); PG8_MMA(1, 0, At, B0); PG8_BAR; PG8_SCHED;
            PG8_STAGE(PG8_SB(1, 1), b3 + hstep, voffB);
            PG8_WAIT_V(6); PG8_BAR; PG8_MMA(1, 1, At, B1); PG8_BAR;
            }
        }
        if constexpr (ALIGN_EPI) { if (wr == 0) PG8_BAR; }
        if constexpr (!Epi::AFTER_DRAIN) { E(acc, cur, wr, wc, fr, fq); S.done(cur); }
        if (!has_next) break;
#pragma unroll
        for (int a = 0; a < 2; ++a)
#pragma unroll
            for (int b = 0; b < 2; ++b)
#pragma unroll
                for (int m = 0; m < 4; ++m)
#pragma unroll
                    for (int n = 0; n < 2; ++n) acc[a][b][m][n] = (f32x4){0.f, 0.f, 0.f, 0.f};
        cur = nxt; cA = nA; cB = nB; ++ui;
        if constexpr (ALIGN_EPI) { if (wr == 1) PG8_BAR; }
    }
    PG8_WAIT_V(0);
    if constexpr (!ALIGN_EPI) { if (wr == 0) PG8_BAR; }
    PG8_BAR;
    if constexpr (Epi::AFTER_DRAIN) { E.fused(acc, cur, wr, wc, fr, fq, lds, wid, lane); S.done(cur); }
#undef PG8_SA
#undef PG8_SB
#undef PG8_STAGE
#undef PG8_LDA
#undef PG8_LDB
#undef PG8_MMA
#undef PG8_WAIT_V
#undef PG8_WAIT_L
#undef PG8_BAR
#undef PG8_SCHED
}
}
namespace att {
#define ATT_LAS __attribute__((address_space(3)))
typedef short bf16x8 __attribute__((ext_vector_type(8)));
typedef float f32x16 __attribute__((ext_vector_type(16)));
typedef float f32x4 __attribute__((ext_vector_type(4)));
typedef unsigned u32x4 __attribute__((ext_vector_type(4)));
typedef unsigned u32x2 __attribute__((ext_vector_type(2)));
typedef unsigned short bf16_t;
constexpr int KROW = 272, VROW = 136, KBYTES = 64 * KROW, VBYTES = 128 * VROW, BUF = KBYTES + VBYTES;
constexpr int KM_OFF = 2 * BUF;
constexpr int ATT_LDS = KM_OFF + 8192;
constexpr float NEG = -1.0e30f;
constexpr int SEQ = 4096, MROWS = 8192;
__device__ __forceinline__ int crow(int r, int hi) { return (r & 3) + 8 * (r >> 2) + 4 * hi; }
typedef float f32x2a_t __attribute__((ext_vector_type(2))); typedef __bf16 bf16x2a_t __attribute__((ext_vector_type(2)));
__device__ __forceinline__ unsigned cvtpk(float lo, float hi) { f32x2a_t v = {lo, hi}; bf16x2a_t b = __builtin_convertvector(v, bf16x2a_t); return __builtin_bit_cast(unsigned, b); }
#define ATT_BAR() asm volatile("s_waitcnt lgkmcnt(0)\n\ts_barrier" ::: "memory")
#define ATT_MFMA(a, b, c) __builtin_amdgcn_mfma_f32_32x32x16_bf16((a), (b), (c), 0, 0, 0)

struct TileRegs { u32x4 k[2]; u32x4 v[2]; };
__device__ __forceinline__ void tile_load(TileRegs& t, const bf16_t* Kh, const bf16_t* Vth, int kv0, int tid) {
    const char* kt = (const char*)(Kh + (size_t)kv0 * 1024); const char* vt = (const char*)(Vth + kv0);
#pragma unroll
    for (int i = 0; i < 2; ++i) { const unsigned c = (unsigned)tid + 512u * i;
        t.k[i] = *(const u32x4*)(kt + (((c >> 4) * 1024u + (c & 15u) * 8u) * 2u));
        t.v[i] = *(const u32x4*)(vt + (((c >> 3) * (unsigned)MROWS + (c & 7u) * 8u) * 2u)); }
}
__device__ __forceinline__ void tile_store(const TileRegs& t, ATT_LAS unsigned char* buf, int tid) {
#pragma unroll
    for (int i = 0; i < 2; ++i) { const int c = tid + 512 * i;
        *(ATT_LAS u32x4*)(buf + (c >> 4) * KROW + (c & 15) * 16) = t.k[i];
        ATT_LAS u32x2* vp = (ATT_LAS u32x2*)(buf + KBYTES + (c >> 3) * VROW + (c & 7) * 16);
        vp[0] = (u32x2){t.v[i].x, t.v[i].y}; vp[1] = (u32x2){t.v[i].z, t.v[i].w}; }
}
__device__ __forceinline__ void softmax_step(f32x16& s, float& m, float& l, f32x16 (&o)[4]) {
    float mx = s[0];
#pragma unroll
    for (int r = 1; r < 16; ++r) mx = fmaxf(mx, s[r]);
    mx = fmaxf(mx, __shfl_xor(mx, 32));
    const float mn = fmaxf(m, mx);
    const float sc = __builtin_amdgcn_exp2f(m - mn);
    m = mn;
    float ps = 0.f;
#pragma unroll
    for (int r = 0; r < 16; ++r) { const float p = __builtin_amdgcn_exp2f(s[r] - mn); s[r] = p; ps += p; }
    l = l * sc + ps;
    if (__builtin_amdgcn_ballot_w64(sc != 1.0f) != 0ull) {
#pragma unroll
        for (int db = 0; db < 4; ++db)
#pragma unroll
            for (int r = 0; r < 16; ++r) o[db][r] *= sc;
    }
}
__device__ __forceinline__ bf16x8 pack8(const f32x16& p, int c) {
    u32x4 w; w.x = cvtpk(p[8 * c], p[8 * c + 1]); w.y = cvtpk(p[8 * c + 2], p[8 * c + 3]); w.z = cvtpk(p[8 * c + 4], p[8 * c + 5]); w.w = cvtpk(p[8 * c + 6], p[8 * c + 7]);
    return __builtin_bit_cast(bf16x8, w);
}
__device__ __forceinline__ bf16x8 vfrag(const ATT_LAS unsigned char* vb, int db, int sub, int c, int r32, int hi) {
    const ATT_LAS unsigned char* p = vb + (32 * db + r32) * VROW + (32 * sub + 16 * c + 4 * hi) * 2;
    const u32x2 lo = *(const ATT_LAS u32x2*)p, h2 = *(const ATT_LAS u32x2*)(p + 16);
    u32x4 w; w.x = lo.x; w.y = lo.y; w.z = h2.x; w.w = h2.y; return __builtin_bit_cast(bf16x8, w);
}


__device__ __forceinline__ void kfrag4(bf16x8& k0, bf16x8& k1, bf16x8& k2, bf16x8& k3, unsigned addr) {
    asm volatile("ds_read_b128 %0, %4\n\tds_read_b128 %1, %4 offset:32\n\tds_read_b128 %2, %4 offset:64\n\tds_read_b128 %3, %4 offset:96\n\ts_waitcnt lgkmcnt(0)"
                 : "=&v"(k0), "=&v"(k1), "=&v"(k2), "=&v"(k3) : "v"(addr) : "memory");
}

typedef float f32x2 __attribute__((ext_vector_type(2)));
constexpr float THR = 8.0f;
__device__ __forceinline__ float max3f(float a, float b, float c) { return __builtin_fmaxf(__builtin_fmaxf(a, b), c); }
template <int NST>
__device__ __forceinline__ void subtile(const ATT_LAS unsigned char* kp  , const ATT_LAS unsigned char* vb, int sub,
                                        const bf16x8 (&q)[NST], float& m, float& l, f32x16 (&o)[4], int r32, int hi, bool straddle, bool gated, bool lane_on) {
    f32x16 s;
#pragma unroll
    for (int r = 0; r < 16; ++r) s[r] = 0.f;
#pragma unroll
    for (int hh = 0; hh < NST / 4; ++hh) { bf16x8 k0, k1, k2, k3; kfrag4(k0, k1, k2, k3, (unsigned)(uintptr_t)(kp + 128 * hh));
        s = ATT_MFMA(k0, q[4 * hh], s); s = ATT_MFMA(k1, q[4 * hh + 1], s); s = ATT_MFMA(k2, q[4 * hh + 2], s); s = ATT_MFMA(k3, q[4 * hh + 3], s); }
    if (straddle) {
        const int lim = r32 - 4 * hi;
#pragma unroll
        for (int r = 0; r < 16; ++r) s[r] = ((r & 3) + 8 * (r >> 2) > lim) ? NEG : s[r];
    }
    if (__builtin_amdgcn_ballot_w64(m != 0.f) != 0ull) {
#pragma unroll
        for (int r = 0; r < 16; ++r) s[r] -= m;
    }
    float mx = max3f(s[0], s[1], s[2]);
#pragma unroll
    for (int r = 3; r < 15; r += 2) mx = max3f(mx, s[r], s[r + 1]);
    mx = __builtin_fmaxf(mx, s[15]);
    { auto rr = __builtin_amdgcn_permlane32_swap(__float_as_uint(mx), __float_as_uint(mx), false, false); mx = __builtin_fmaxf(__uint_as_float(rr[0]), __uint_as_float(rr[1])); }
    if (gated) mx = lane_on ? mx : NEG;
    if (__builtin_amdgcn_ballot_w64(mx > THR) != 0ull) {
        const float dl = mx > THR ? mx : 0.f, sc = __builtin_amdgcn_exp2f(-dl);
        m += dl; l *= sc;
#pragma unroll
        for (int r = 0; r < 16; ++r) s[r] -= dl;
#pragma unroll
        for (int db = 0; db < 4; ++db)
#pragma unroll
            for (int r = 0; r < 16; ++r) o[db][r] *= sc;
    }
#pragma unroll
    for (int r = 0; r < 16; ++r) s[r] = __builtin_amdgcn_exp2f(s[r]);
    f32x2 ps = (f32x2){s[0], s[1]};
#pragma unroll
    for (int r = 2; r < 16; r += 2) ps += (f32x2){s[r], s[r + 1]};
    const float psum = ps.x + ps.y;
    const unsigned pmask = (gated && !lane_on) ? 0u : 0xffffffffu;
    l += (gated && !lane_on) ? 0.f : psum;
#pragma unroll
    for (int c = 0; c < 2; ++c) {
        u32x4 w; w.x = cvtpk(s[8 * c], s[8 * c + 1]); w.y = cvtpk(s[8 * c + 2], s[8 * c + 3]); w.z = cvtpk(s[8 * c + 4], s[8 * c + 5]); w.w = cvtpk(s[8 * c + 6], s[8 * c + 7]);
        if (gated) { w.x &= pmask; w.y &= pmask; w.z &= pmask; w.w &= pmask; }
        const bf16x8 pb = __builtin_bit_cast(bf16x8, w);
#pragma unroll
        for (int db = 0; db < 4; ++db) o[db] = ATT_MFMA(vfrag(vb, db, sub, c, r32, hi), pb, o[db]);
    }
}

__device__ __forceinline__ void moba_unit(int b, int h, int qb, const bf16_t* QA, const bf16_t* KA, const bf16_t* VT, const float* kmean, bf16_t* YA, ATT_LAS unsigned char* lds) {
    int tid = threadIdx.x; asm volatile("" : "+v"(tid));
    const int lane = tid & 63, r32 = lane & 31, hi = lane >> 5, wid = __builtin_amdgcn_readfirstlane(tid >> 6);
    const bf16_t* Kh = KA + (size_t)b * SEQ * 1024 + h * 128;
    const bf16_t* Vth = VT + (size_t)(h * 128) * MROWS + (size_t)b * SEQ;
    const int qrow = b * SEQ + qb * 256 + wid * 32 + r32;
    __syncthreads();
    { ATT_LAS float* km = (ATT_LAS float*)(lds + KM_OFF); const float* src = kmean + (size_t)((b * 8 + h) * 16) * 128;
      for (int i = tid; i < 2048; i += 512) km[i] = src[i]; }
    bf16x8 qr[8];
#pragma unroll
    for (int st = 0; st < 8; ++st) qr[st] = *(const bf16x8*)(QA + (size_t)qrow * 1024 + h * 128 + st * 16 + hi * 8);
    TileRegs tr; tile_load(tr, Kh, Vth, 0, tid); tile_store(tr, lds, tid);
#pragma unroll
    for (int st = 0; st < 8; ++st) asm volatile("" : "+v"(qr[st]));
    __syncthreads();
    unsigned sel = 0u;
    if (qb > 0) {
        float v1 = -INFINITY, v2 = -INFINITY, v3 = -INFINITY; int i1 = 31, i2 = 31, i3 = 31;
        for (int j = 0; j < qb; ++j) {
            const ATT_LAS float* km = (const ATT_LAS float*)(lds + KM_OFF) + j * 128 + hi * 8;
            float dot = 0.f;
#pragma unroll
            for (int st = 0; st < 8; ++st) { const f32x4 k0 = *(const ATT_LAS f32x4*)(km + st * 16), k1 = *(const ATT_LAS f32x4*)(km + st * 16 + 4);
                const u32x4 qw = __builtin_bit_cast(u32x4, qr[st]);
                dot += __uint_as_float(qw.x << 16) * k0[0] + __uint_as_float(qw.x & 0xffff0000u) * k0[1] + __uint_as_float(qw.y << 16) * k0[2] + __uint_as_float(qw.y & 0xffff0000u) * k0[3]
                     + __uint_as_float(qw.z << 16) * k1[0] + __uint_as_float(qw.z & 0xffff0000u) * k1[1] + __uint_as_float(qw.w << 16) * k1[2] + __uint_as_float(qw.w & 0xffff0000u) * k1[3]; }
            dot += __shfl_xor(dot, 32);
            if (dot > v1) { v3 = v2; i3 = i2; v2 = v1; i2 = i1; v1 = dot; i1 = j; }
            else if (dot > v2) { v3 = v2; i3 = i2; v2 = dot; i2 = j; }
            else if (dot > v3) { v3 = dot; i3 = j; }
        }
        sel = (1u << i1) | (1u << i2) | (1u << i3);
    }
    f32x16 o[4];
#pragma unroll
    for (int db = 0; db < 4; ++db)
#pragma unroll
        for (int r = 0; r < 16; ++r) o[db][r] = 0.f;
    float m = 0.f, l = 0.f;
    const int NS = 4 * (qb + 1);
#pragma unroll 1
    for (int i = 0; i < NS; ++i) {
        const int j = i >> 2, t = i & 3;
        if (i + 1 < NS) tile_load(tr, Kh, Vth, (i + 1) * 64, tid);
        const ATT_LAS unsigned char* kb = lds + (i & 1) * BUF; const ATT_LAS unsigned char* vb = kb + KBYTES;
        const bool own = (j == qb), lane_on = own || ((sel >> j) & 1u);
#pragma unroll 1
        for (int sub = 0; sub < 2; ++sub) {
            const int kvblk = 2 * t + sub;
            if (own && kvblk > wid) break;
            subtile<8>(kb + (32 * sub + r32) * KROW + 16 * hi, vb, sub, qr, m, l, o, r32, hi, own && kvblk == wid, !own, lane_on);
        }
        if (i + 1 < NS) tile_store(tr, lds + ((i + 1) & 1) * BUF, tid);
        ATT_BAR();
    }
    l += __shfl_xor(l, 32);
    const float inv = 1.0f / l;
    bf16_t* yp = YA + (size_t)qrow * 1024 + h * 128 + 4 * hi;
#pragma unroll
    for (int db = 0; db < 4; ++db)
#pragma unroll
        for (int g = 0; g < 4; ++g) { u32x2 w; w.x = cvtpk(o[db][4 * g] * inv, o[db][4 * g + 1] * inv); w.y = cvtpk(o[db][4 * g + 2] * inv, o[db][4 * g + 3] * inv);
            *(u32x2*)(yp + 32 * db + 8 * g) = w; }
}

__device__ __forceinline__ void diff_unit128(int b, int h, int qi, const bf16_t* QB, const bf16_t* KB, const bf16_t* VT, const float* subln_w, float lam, float out_scale, bf16_t* YB, ATT_LAS unsigned char* lds) {
    int tid = threadIdx.x; asm volatile("" : "+v"(tid));
    const int lane = tid & 63, r32 = lane & 31, hi = lane >> 5, wid = __builtin_amdgcn_readfirstlane(tid >> 6), grp = wid >> 2, wrow = wid & 3;
    const bf16_t* Kh = KB + (size_t)b * SEQ * 1024 + h * 128;
    const bf16_t* Vth = VT + (size_t)(1024 + h * 128) * MROWS + (size_t)b * SEQ;
    const int NS = 2 * (qi + 1), ql = wrow * 32 + r32, qrow = b * SEQ + qi * 128 + ql, koff = grp * 64;
    __syncthreads();
    bf16x8 q[4];
#pragma unroll
    for (int st = 0; st < 4; ++st) q[st] = *(const bf16x8*)(QB + (size_t)qrow * 1024 + h * 128 + koff + st * 16 + hi * 8);
    TileRegs tr; tile_load(tr, Kh, Vth, 0, tid); tile_store(tr, lds, tid);
#pragma unroll
    for (int st = 0; st < 4; ++st) asm volatile("" : "+v"(q[st]));
    __syncthreads();
    f32x16 o[4];
#pragma unroll
    for (int db = 0; db < 4; ++db)
#pragma unroll
        for (int r = 0; r < 16; ++r) o[db][r] = 0.f;
    float m = 0.f, l = 0.f;
#pragma unroll 1
    for (int i = 0; i < NS; ++i) {
        if (i + 1 < NS) tile_load(tr, Kh, Vth, (i + 1) * 64, tid);
        const ATT_LAS unsigned char* kb = lds + (i & 1) * BUF; const ATT_LAS unsigned char* vb = kb + KBYTES;
        const int t = i - 2 * qi;
#pragma unroll 1
        for (int sub = 0; sub < 2; ++sub) {
            const int kvblk = 2 * t + sub;
            if (t >= 0 && kvblk > wrow) break;
            subtile<4>(kb + (32 * sub + r32) * KROW + koff * 2 + 16 * hi, vb, sub, q, m, l, o, r32, hi, t >= 0 && kvblk == wrow, false, true);
        }
        if (i + 1 < NS) tile_store(tr, lds + ((i + 1) & 1) * BUF, tid);
        ATT_BAR();
    }
    l += __shfl_xor(l, 32);
    ATT_LAS float* xs = (ATT_LAS float*)lds + (wrow * 64) * 64 + lane;
    if (grp == 1) {
        const float i2 = lam / l;
#pragma unroll
        for (int db = 0; db < 4; ++db)
#pragma unroll
            for (int r = 0; r < 16; ++r) xs[(db * 16 + r) * 64] = o[db][r] * i2;
    }
    __syncthreads();
    if (grp == 0) {
        const float i1 = 1.0f / l;
        float ss = 0.f;
#pragma unroll
        for (int db = 0; db < 4; ++db)
#pragma unroll
            for (int r = 0; r < 16; ++r) { const float v = o[db][r] * i1 - xs[(db * 16 + r) * 64]; o[db][r] = v; ss += v * v; }
        ss += __shfl_xor(ss, 32);
        const float rs = out_scale / sqrtf(ss * (1.0f / 128.0f) + 1e-5f);
        bf16_t* yp = YB + (size_t)qrow * 1024 + h * 128 + 4 * hi;
#pragma unroll
        for (int db = 0; db < 4; ++db)
#pragma unroll
            for (int g = 0; g < 4; ++g) { const f32x4 w4 = *(const f32x4*)(subln_w + 32 * db + 8 * g + 4 * hi);
                u32x2 w; w.x = cvtpk(o[db][4 * g] * rs * w4[0], o[db][4 * g + 1] * rs * w4[1]); w.y = cvtpk(o[db][4 * g + 2] * rs * w4[2], o[db][4 * g + 3] * rs * w4[3]);
                *(u32x2*)(yp + 32 * db + 8 * g) = w;
                if (g & 1) asm volatile("" ::: "memory"); }
    }
}
}
namespace cg = cooperative_groups;
#ifndef MK_N_LAUNCHES
#define MK_N_LAUNCHES 1
#define MK_DUMP 0
#define MK_DUMP_PH 2
#define MK_DUMP_OFF (WS_R2 + 64 * MiB)
#endif
constexpr int NPHASE = 9;
#ifndef MK_REP_P2
#define MK_REP_P2 1
#endif
#ifndef MK_REP_P0
#define MK_REP_P0 2
#endif
#ifndef MK_REPS
#define MK_REPS 1
#endif
constexpr int NWAVES = 8;
constexpr int M = 8192, DM = 2048, SEQ = 4096, NIN = 8192  , FFH = 5632;
constexpr float LN_EPS = 1e-5f;
constexpr float ALPHA = 1.189207115002721f;
constexpr float SC_A = 0.08838834764831845f * 1.4426950408889634f, SC_B = 0.125f * 1.4426950408889634f;
constexpr float LAM_INIT = 0.2f;

constexpr size_t MiB = 1u << 20;
constexpr size_t WS_WIN = 1 * MiB, WS_WV = 33 * MiB, WS_WBA = 41 * MiB, WS_WBB = 45 * MiB, WS_WOUT = 49 * MiB, WS_WFI = 57 * MiB, WS_WFO = 101 * MiB;
constexpr size_t WS_T128 = 123 * MiB, WS_T64 = 125 * MiB, WS_KM = 126 * MiB;
constexpr size_t WS_R1 = 128 * MiB;
constexpr size_t WS_R2 = 160 * MiB;
constexpr size_t WS_R3 = 288 * MiB;
constexpr size_t WS_END = 320 * MiB;
constexpr int MISC_OFF = 131072, LDS_BYTES = 131072 + 1024;
constexpr size_t WS_CTL = 0, CTL_ZERO_BYTES = 65536;
constexpr int SCHED_N = 4;
__device__ const unsigned char SCHED[32 * SCHED_N] = {15,4,255,255,47,36,255,255,14,76,65,255,46,108,97,255,13,77,0,255,45,109,32,255,12,37,1,255,44,110,68,255,95,5,75,255,127,78,107,255,94,79,74,255,126,111,106,255,11,6,33,255,93,38,100,255,43,80,3,255,125,112,73,255,92,81,35,255,124,113,105,255,91,82,72,255,123,114,104,255,10,39,67,255,42,115,99,255,90,7,71,255,122,83,103,255,89,84,2,255,121,116,34,255,9,8,66,64,88,40,98,96,41,85,70,255,120,117,102,255,87,86,69,255,119,118,101,255};

#define LAS __attribute__((address_space(3)))
typedef unsigned short bf16;
typedef unsigned v4u __attribute__((ext_vector_type(4)));
typedef unsigned v2u __attribute__((ext_vector_type(2)));
typedef float f32x4 __attribute__((ext_vector_type(4)));
__device__ __forceinline__ unsigned f2bf(float f) { unsigned u = __builtin_bit_cast(unsigned, f); return (u + 0x7fffu + ((u >> 16) & 1u)) >> 16; }
__device__ __forceinline__ unsigned pk2(float lo, float hi) { return f2bf(lo) | (f2bf(hi) << 16); }
__device__ __forceinline__ float wave_sum(float v) {
#pragma unroll
    for (int o = 1; o < 64; o <<= 1) v += __shfl_xor(v, o);
    return v;
}
#define XB_TMO      128
#define XB_XCNT(j)  (256  + 64 * (j))
#define XB_XSUB(j)  (1280 + 64 * (j))
#define XB_XGEN(j)  (2304 + 64 * (j))
#define XB_TOP      3328
#define XB_TOPGEN   3392
#define XCD_BAR_WORDS 3456
#define XB_SPIN_CAP (1u << 18)

__device__ __forceinline__ unsigned xb_ld(unsigned* p)              { return __hip_atomic_load(p, __ATOMIC_RELAXED, __HIP_MEMORY_SCOPE_AGENT); }
__device__ __forceinline__ unsigned xb_add(unsigned* p, unsigned v) { return __hip_atomic_fetch_add(p, v, __ATOMIC_RELAXED, __HIP_MEMORY_SCOPE_AGENT); }
__device__ __forceinline__ unsigned xb_xcc_id() { return (unsigned)__builtin_amdgcn_s_getreg((3 << 11) | 20) & 0xFu; }
#define XB_SPIN(cond, bar) do { unsigned _sp = 0; while (cond) { __builtin_amdgcn_s_sleep(1); \
    if ((++_sp & 255u) == 0u) { if (xb_ld(&(bar)[XB_TMO])) break; if (_sp > XB_SPIN_CAP) { atomicAdd(&(bar)[XB_TMO], 1u); break; } } } } while (0)

struct XcdBarrier {
    unsigned* bar; unsigned x;
    volatile LAS unsigned* st;
};

__device__ __forceinline__ XcdBarrier xcd_barrier_post(unsigned* bar, volatile LAS unsigned* st) {
    XcdBarrier b; b.bar = bar; b.x = xb_xcc_id(); b.st = st;
    if (threadIdx.x == 0) (void)xb_add(&bar[XB_XCNT(b.x)], 1u);
    return b;
}
__device__ __forceinline__ void xcd_barrier_complete(unsigned* bar, unsigned x, unsigned& nloc, unsigned& nx) {
    const unsigned G = gridDim.x * gridDim.y * gridDim.z;
    unsigned sum, cnt, mine, sp = 0u;
    for (;;) {
        sum = 0u; cnt = 0u; mine = 0u;
#pragma unroll
        for (unsigned j = 0; j < 16; ++j) { const unsigned c = xb_ld(&bar[XB_XCNT(j)]); sum += c; cnt += (c > 0u) ? 1u : 0u; mine = (j == x) ? c : mine; }
        if (sum == G) break;
        __builtin_amdgcn_s_sleep(1);
        if ((++sp & 255u) == 0u) { if (xb_ld(&bar[XB_TMO])) break; if (sp > XB_SPIN_CAP) { atomicAdd(&bar[XB_TMO], 1u); break; } }
    }
    nloc = mine > 0u ? mine : 1u; nx = cnt > 0u ? cnt : 1u;
}

__device__ __forceinline__ void xcd_barrier(const XcdBarrier& b) {
    asm volatile("s_waitcnt vmcnt(0)" ::: "memory");
    __syncthreads();
    if (threadIdx.x == 0) {
        unsigned* bar = b.bar;
        __builtin_amdgcn_s_waitcnt(0);
        unsigned nloc = b.st[0], nx = b.st[1];
        if (nloc == 0u) { xcd_barrier_complete(bar, b.x, nloc, nx); b.st[0] = nloc; b.st[1] = nx; }
        const unsigned old = xb_add(&bar[XB_XSUB(b.x)], 1u);
        const unsigned gen = old / nloc;
        if (old + 1u == (gen + 1u) * nloc) {
            __builtin_amdgcn_fence(__ATOMIC_RELEASE, "agent");
            asm volatile("s_waitcnt vmcnt(0)" ::: "memory");
            const unsigned og = xb_add(&bar[XB_TOP], 1u);
            const unsigned tg = og / nx;
            if (og + 1u == (tg + 1u) * nx) xb_add(&bar[XB_TOPGEN], 1u);
            else XB_SPIN(xb_ld(&bar[XB_TOPGEN]) == tg, bar);
            __builtin_amdgcn_fence(__ATOMIC_ACQUIRE, "agent");
            xb_add(&bar[XB_XGEN(b.x)], 1u);
            asm volatile("s_waitcnt vmcnt(0)" ::: "memory");
        } else {
            XB_SPIN(xb_ld(&bar[XB_XGEN(b.x)]) == gen, bar);
            __builtin_amdgcn_fence(__ATOMIC_ACQUIRE, "agent");
            asm volatile("s_waitcnt vmcnt(0)" ::: "memory");
        }
    }
    __syncthreads();
}
__device__ __forceinline__ int src_col_in(int g) {
    if (g >= 4096) return g + 2048;
    const int region = g >> 10, h = (g >> 7) & 7, gl = g & 127, e = gl & 7, blk = gl >> 3;
    const int base = region == 0 ? 0 : region == 1 ? 1024 : region == 2 ? 3072 : 4096;
    const int d = region < 2 ? 4 * blk + (e & 3) + 64 * (e >> 2) : (blk >> 3) * 64 + 4 * (blk & 7) + (e & 3) + 32 * (e >> 2);
    return base + h * 128 + d;
}
__device__ __forceinline__ void p0_item(const float* W, int K, int N, int Ndst, bf16* WT, LAS float* scr, int item, int lane, int mode, int src_off) {
    const int nblk = Ndst / 32, kb = item / nblk, nb = item % nblk, k0 = 64 * kb, g0 = 32 * nb;
    const int g = g0 + (lane & 31);
    const int sc = mode == 0 ? src_off + g : (mode == 1 ? src_col_in(g) : ((g >> 7) & 1) * 5632 + 128 * (g >> 8) + (g & 127));
#pragma unroll 8
    for (int i = 0; i < 32; ++i) { const int kk = 2 * i + (lane >> 5); scr[kk * 33 + (lane & 31)] = W[(size_t)(k0 + kk) * N + sc]; }
    asm volatile("s_waitcnt lgkmcnt(0)" ::: "memory");
    const int c = lane & 7;
#pragma unroll
    for (int j = 0; j < 4; ++j) { const int n = (lane >> 3) + 8 * j; const LAS float* s = scr + (8 * c) * 33 + n;
        v4u o; o.x = pk2(s[0 * 33], s[1 * 33]); o.y = pk2(s[2 * 33], s[3 * 33]); o.z = pk2(s[4 * 33], s[5 * 33]); o.w = pk2(s[6 * 33], s[7 * 33]);
        *(v4u*)(WT + (size_t)(g0 + n) * K + k0 + 8 * c) = o; }
    asm volatile("s_waitcnt lgkmcnt(0)" ::: "memory");
}
__device__ __forceinline__ void ln_row(float* row, const float* gam, const float* bet, bf16* brow, int lane) {
    f32x4* xr = (f32x4*)row + lane; f32x4 v[8]; float s = 0.f;
#pragma unroll
    for (int j = 0; j < 8; ++j) { v[j] = xr[64 * j]; s += (v[j].x + v[j].y) + (v[j].z + v[j].w); }
    const float mean = wave_sum(s) * (1.f / 2048.f); float s2 = 0.f;
#pragma unroll
    for (int j = 0; j < 8; ++j) { v[j] = v[j] - mean; s2 += (v[j].x * v[j].x + v[j].y * v[j].y) + (v[j].z * v[j].z + v[j].w * v[j].w); }
    const float rstd = 1.f / sqrtf(wave_sum(s2) * (1.f / 2048.f) + LN_EPS);
#pragma unroll
    for (int j = 0; j < 8; ++j) { const f32x4 g4 = *((const f32x4*)gam + 64 * j + lane), b4 = *((const f32x4*)bet + 64 * j + lane);
        const f32x4 o = v[j] * rstd * g4 + b4; xr[64 * j] = o;
        if (brow) { v2u w; w.x = pk2(o.x, o.y); w.y = pk2(o.z, o.w); *((v2u*)brow + 64 * j + lane) = w; } }
}

struct Args { const float* in[13]; float* out; unsigned char* ws; int ph_lo, ph_hi, coop, pad; };
__global__ void __launch_bounds__(NWAVES * 64, 2) mk_fwd(Args args) {
    extern __shared__ __attribute__((aligned(16))) unsigned char lds_raw[];
    LAS unsigned char* lds = (LAS unsigned char*)lds_raw;
    const int wave = __builtin_amdgcn_readfirstlane(threadIdx.x >> 6);
    const int G = gridDim.x, bx = blockIdx.x, vcu = (G % 8 == 0) ? (bx % 8) * (G / 8) + bx / 8 : bx;
    unsigned char* ws = args.ws;
    const float* x = args.in[0]; const float* w_in = args.in[1]; const float* lambda_qk = args.in[2]; const float* subln_w = args.in[3];
    const float* w_ba = args.in[4]; const float* w_bb = args.in[5]; const float* w_out = args.in[6]; const float* ln1_g = args.in[7]; const float* ln1_b = args.in[8];
    const float* w_fi = args.in[9]; const float* w_fo = args.in[10]; const float* ln2_g = args.in[11]; const float* ln2_b = args.in[12];
    float* out = args.out;
    bf16* WinT = (bf16*)(ws + WS_WIN); bf16* WvT = (bf16*)(ws + WS_WV); bf16* WbaT = (bf16*)(ws + WS_WBA); bf16* WbbT = (bf16*)(ws + WS_WBB);
    bf16* WoutT = (bf16*)(ws + WS_WOUT); bf16* WfiT = (bf16*)(ws + WS_WFI); bf16* WfoT = (bf16*)(ws + WS_WFO);
    float* T128 = (float*)(ws + WS_T128); float* T64 = (float*)(ws + WS_T64); float* kmean = (float*)(ws + WS_KM);
    bf16* XB = (bf16*)(ws + WS_R1); bf16* YA = (bf16*)(ws + WS_R1); bf16* YB = YA + (size_t)M * 1024; bf16* H1B = (bf16*)(ws + WS_R1);
    bf16* QK = (bf16*)(ws + WS_R2); bf16* SG = QK + (size_t)4 * M * 1024; bf16* HID = (bf16*)(ws + WS_R2);
    bf16* VT = (bf16*)(ws + WS_R3); bf16* MB = (bf16*)(ws + WS_R3);
    const int lo = args.ph_lo, hi = args.ph_hi;
#ifdef ONLY_PHASE
#define IN(k) ((k) == ONLY_PHASE && lo <= (k) && (k) < hi)
#else
#define IN(k) (lo <= (k) && (k) < hi)
#endif
#define SEAM(k) do { if (args.coop && IN(k) && IN((k) + 1)) xcd_barrier(bar); } while (0)
    const int gw = vcu * NWAVES + wave, NGW = G * NWAVES, NGT = G * NWAVES * 64;
    volatile LAS unsigned* MISC = (volatile LAS unsigned*)(lds + MISC_OFF);
    if (threadIdx.x < 32) MISC[threadIdx.x] = 0u;
    __syncthreads();
    XcdBarrier bar; bar.bar = (unsigned*)(ws + WS_CTL); bar.x = 0; bar.st = nullptr;
    if (args.coop) bar = xcd_barrier_post((unsigned*)(ws + WS_CTL), MISC + 8);
    if (args.pad == 0x5a5a) cg::this_grid().sync();

    if (IN(0)) {
        const int tid = threadIdx.x, lane = tid & 63, gt = bx * (NWAVES * 64) + tid;
        LAS float* scr = (LAS float*)(lds + wave * 16384);
        constexpr int I_IN = (DM / 64) * (NIN / 32), I_V = (DM / 64) * (2048 / 32), I_BA = (1024 / 64) * (2048 / 32), I_OUT = (DM / 64) * (2048 / 32), I_FI = (DM / 64) * (2 * FFH / 32), I_FO = (FFH / 64) * (2048 / 32);
        constexpr int NITEMS = I_IN + I_V + 2 * I_BA + I_OUT + I_FI + I_FO;
        for (int it = gw; it < NITEMS; it += NGW) {
            int r = it;
            if (r < I_IN) { p0_item(w_in, DM, 10240, NIN, WinT, scr, r, lane, 1, 0); continue; } r -= I_IN;
            if (r < I_V) { const int nblk = 2048 / 32, nb = r % nblk; p0_item(w_in, DM, 10240, 2048, WvT, scr, r, lane, 0, nb < 32 ? 2048 : 5120 - 1024); continue; } r -= I_V;
            if (r < I_BA) { p0_item(w_ba, 1024, 2048, 2048, WbaT, scr, r, lane, 0, 0); continue; } r -= I_BA;
            if (r < I_BA) { p0_item(w_bb, 1024, 2048, 2048, WbbT, scr, r, lane, 0, 0); continue; } r -= I_BA;
            if (r < I_OUT) { p0_item(w_out, DM, 2048, 2048, WoutT, scr, r, lane, 0, 0); continue; } r -= I_OUT;
            if (r < I_FI) { p0_item(w_fi, DM, 2 * FFH, 2 * FFH, WfiT, scr, r, lane, 2, 0); continue; } r -= I_FI;
            p0_item(w_fo, FFH, 2048, 2048, WfoT, scr, r, lane, 0, 0);
        }
        for (int i = gt; i < M * DM / 8; i += NGT) { const f32x4 a = *((const f32x4*)x + 2 * (size_t)i), b = *((const f32x4*)x + 2 * (size_t)i + 1);
            v4u o; o.x = pk2(a.x, a.y); o.y = pk2(a.z, a.w); o.z = pk2(b.x, b.y); o.w = pk2(b.z, b.w); *((v4u*)XB + i) = o; }
        for (int i = gt; i < SEQ * 96; i += NGT) {
            int pos, f, half; float* tab;
            if (i < SEQ * 64) { pos = i >> 6; f = i & 63; half = 64; tab = T128; } else { const int k = i - SEQ * 64; pos = k >> 5; f = k & 31; half = 32; tab = T64; }
            const float inv_freq = (float)exp2(-(double)f / (double)half * 13.287712379549449);
            const float ang = (float)pos * inv_freq;
            double tt = (double)ang * 0.15915494309189535; tt -= floor(tt);
            tab[(size_t)pos * half + f] = __builtin_amdgcn_cosf((float)tt); tab[(size_t)(SEQ + pos) * half + f] = __builtin_amdgcn_sinf((float)tt);
        }
        for (int i = gt; i < 2 * 8 * 16 * 128; i += NGT) kmean[i] = 0.f;
    }
    SEAM(0);
    if (IN(1)) {
        { pg8::Gemm g{XB, WinT, M, NIN, DM}; pg8::StaticOrder S; S.init(M, NIN, G, bx);
          pg8::EpiIn E{QK, SG, T128, T64, kmean, SC_A, SC_B};
          pg8::gemm_phase<pg8::EpiIn, pg8::StaticOrder, true, true>(lds, g, S, E); }
        { pg8::Gemm g{WvT, XB, 2048, M, DM}; pg8::StaticOrder S; S.init(2048, M, G, bx);
          pg8::EpiStore E{VT, M};
          pg8::gemm_phase<pg8::EpiStore, pg8::StaticOrder, true, true>(lds, g, S, E); }
    }
    SEAM(1);
    if (IN(2)) {
        const int lane = threadIdx.x & 63;
        float sa = 0.f, sb = 0.f;
        { const float a = lambda_qk[lane] * lambda_qk[64 + lane], b = lambda_qk[128 + lane] * lambda_qk[192 + lane]; sa = wave_sum(a); sb = wave_sum(b); }
        const float lam = expf(sa) - expf(sb) + LAM_INIT;
        for (int rep2 = 0; rep2 < MK_REP_P2; ++rep2)
        for (int v = vcu; v < 256; v += G) {
            const int xcd = v >> 5, cu = v & 31;
            for (int k = 0; k < SCHED_N; ++k) {
                const int code = SCHED[cu * SCHED_N + k];
                if (code == 255) break;
                const int bh = 2 * xcd + ((code >> 5) & 1), b = bh >> 3, h = bh & 7, idx = code & 31;
                if (code < 64) att::moba_unit(b, h, idx, QK, QK + (size_t)M * 1024, VT, kmean, YA, lds);
                else att::diff_unit128(b, h, idx, QK + (size_t)2 * M * 1024, QK + (size_t)3 * M * 1024, VT, subln_w, lam, 1.0f - LAM_INIT, YB, lds);
            }
        }
        __syncthreads();
    }
    SEAM(2);
    if (IN(3)) {
        { pg8::Gemm g{YA, WbaT, M, DM, 1024}; pg8::StaticOrder S; S.init(M, DM, G, bx);
          pg8::EpiBrA E{out, SG};
          pg8::gemm_phase<pg8::EpiBrA, pg8::StaticOrder, true, true>(lds, g, S, E); }
        { pg8::Gemm g{YB, WbbT, M, DM, 1024}; pg8::StaticOrder S; S.init(M, DM, G, bx);
          pg8::EpiBrB E{out, SG, MB};
          pg8::gemm_phase<pg8::EpiBrB, pg8::StaticOrder, true, true>(lds, g, S, E); }
    }
    SEAM(3);
    if (IN(4)) {
        pg8::Gemm g{MB, WoutT, M, DM, DM}; pg8::StaticOrder S; S.init(M, DM, G, bx);
        pg8::EpiRes E{x, out, ALPHA};
        pg8::gemm_phase<pg8::EpiRes, pg8::StaticOrder, true, true>(lds, g, S, E);
    }
    SEAM(4);
    if (IN(5)) { const int lane = threadIdx.x & 63; for (int m = gw; m < M; m += NGW) ln_row(out + (size_t)m * DM, ln1_g, ln1_b, H1B + (size_t)m * DM, lane); }
    SEAM(5);
    if (IN(6)) {
        pg8::Gemm g{H1B, WfiT, M, 2 * FFH, DM}; pg8::StaticOrder S; S.init(M, 2 * FFH, G, bx);
        pg8::EpiSwiglu E{HID};
        pg8::gemm_phase<pg8::EpiSwiglu, pg8::StaticOrder, true, true>(lds, g, S, E);
    }
    SEAM(6);
    if (IN(7)) {
        pg8::Gemm g{HID, WfoT, M, DM, FFH}; pg8::StaticOrder S; S.init(M, DM, G, bx);
        pg8::EpiRes E{out, out, ALPHA};
        pg8::gemm_phase<pg8::EpiRes, pg8::StaticOrder, true, true>(lds, g, S, E);
    }
    SEAM(7);
    if (IN(8)) { const int lane = threadIdx.x & 63; for (int m = gw; m < M; m += NGW) ln_row(out + (size_t)m * DM, ln2_g, ln2_b, nullptr, lane); }
#undef IN
#undef SEAM
}

__global__ void dump_sum4(const unsigned short* a, const unsigned short* b, const unsigned short* c, const unsigned short* d, float* out, int n) {
    for (int i = blockIdx.x * blockDim.x + threadIdx.x; i < n; i += gridDim.x * blockDim.x)
        out[i] = __uint_as_float((unsigned)a[i] << 16) + __uint_as_float((unsigned)b[i] << 16) + __uint_as_float((unsigned)c[i & (2097152 - 1)] << 16) + __uint_as_float((unsigned)d[i & (2097152 - 1)] << 16); }
__global__ void dump_bf16(const unsigned short* src, float* out, int n) { for (int i = blockIdx.x * blockDim.x + threadIdx.x; i < n; i += gridDim.x * blockDim.x) out[i] = __uint_as_float((unsigned)src[i] << 16); }
#ifndef MK_DUMP
#define MK_DUMP 0
#endif
#ifndef MK_DUMP_PH
#define MK_DUMP_PH 3
#define MK_DUMP_OFF WS_R1
#endif
extern "C" void kernel_launch(void* const* d_in, const int* in_sizes, int n_in, void* d_out, int out_size, void* d_ws, size_t ws_size, hipStream_t stream) {
    static int grid = 0;
    if (grid == 0) {
        if (n_in != 13 || in_sizes[0] != M * DM || out_size != M * DM || ws_size < WS_END) { fprintf(stderr, "kernel_launch: unexpected shapes (n_in %d, in0 %d, out %d, ws %zu); nothing launched\n", n_in, n_in > 0 ? in_sizes[0] : -1, out_size, ws_size); grid = -1; return; }
        int dev = 0, cus = 0, per_cu = 0;
        if (hipGetDevice(&dev) != hipSuccess || hipDeviceGetAttribute(&cus, hipDeviceAttributeMultiprocessorCount, dev) != hipSuccess) { grid = -1; return; }
        if (hipFuncSetAttribute((const void*)mk_fwd, hipFuncAttributeMaxDynamicSharedMemorySize, LDS_BYTES) != hipSuccess) { fprintf(stderr, "kernel_launch: hipFuncSetAttribute failed\n"); grid = -1; return; }
        if (hipOccupancyMaxActiveBlocksPerMultiprocessor(&per_cu, (const void*)mk_fwd, NWAVES * 64, LDS_BYTES) != hipSuccess || per_cu < 1) { fprintf(stderr, "kernel_launch: occupancy query gave %d\n", per_cu); per_cu = 1; }
        (void)hipGetLastError();
        grid = cus * per_cu; if (grid > 256) grid = 256;
        grid -= grid % 8; if (grid < 8) grid = 8;
    }
    if (grid < 0) return;
    if (hipMemsetAsync((char*)d_ws + WS_CTL, 0, CTL_ZERO_BYTES, stream) != hipSuccess) { fprintf(stderr, "kernel_launch: hipMemsetAsync failed\n"); return; }
    Args a{};
    for (int i = 0; i < 13; ++i) a.in[i] = (const float*)d_in[i];
    a.out = (float*)d_out; a.ws = (unsigned char*)d_ws;
    if (MK_N_LAUNCHES == 1) {
        a.ph_lo = 0; a.ph_hi = NPHASE; a.coop = 1;
        void* kargs[] = {&a};
        const hipError_t e = hipLaunchCooperativeKernel((const void*)mk_fwd, dim3(grid), dim3(NWAVES * 64), kargs, LDS_BYTES, stream);
        if (e != hipSuccess) fprintf(stderr, "kernel_launch: cooperative launch failed: %s (grid %d)\n", hipGetErrorString(e), grid);
    } else {
        const int lastp = MK_DUMP == 0 ? NPHASE : MK_DUMP_PH;
        for (int rep = 0; rep < MK_REPS; ++rep) for (int p = 0; p < lastp; ++p) { a.ph_lo = p; a.ph_hi = p + 1; a.coop = 0;
            hipLaunchKernelGGL(mk_fwd, dim3(grid), dim3(NWAVES * 64), LDS_BYTES, stream, a); }
        if (MK_DUMP == 2) { hipLaunchKernelGGL(dump_sum4, dim3(2048), dim3(256), 0, stream, (const unsigned short*)((const char*)d_ws + WS_R2 + 64 * MiB), (const unsigned short*)((const char*)d_ws + WS_R2 + 96 * MiB),
            (const unsigned short*)((const char*)d_ws + WS_WBA), (const unsigned short*)((const char*)d_ws + WS_WBB), (float*)d_out, M * DM); }
        else if (MK_DUMP) { hipLaunchKernelGGL(dump_bf16, dim3(2048), dim3(256), 0, stream, (const unsigned short*)((const char*)d_ws + MK_DUMP_OFF), (float*)d_out, M * DM); }
    }
}
```
